# Optimizing an MI355X kernel written in HIP

```python
import math
import jax, jax.numpy as jnp
from jax import lax
import numpy as np

D_MODEL = 1024
BATCH = 1
SEQ = 16384
DEPTH = 1

ROPE_THETA = 10000.0
NORM_EPS = 1e-6
Q_BLOCK = 128

DIFF_HEADS = 4
DIFF_HEAD_DIM = 64
DIFF_V_DIM = 2 * DIFF_HEAD_DIM
DIFF_WIDTH = DIFF_HEADS * DIFF_V_DIM
DIFF_QK_COLS = DIFF_HEADS * 2 * DIFF_HEAD_DIM

MLA_HEADS = 4
MLA_NOPE = 128
MLA_ROPE = 64
MLA_V = 128
MLA_Q_RANK = 384
MLA_KV_RANK = 256
MLA_WIDTH = MLA_HEADS * MLA_V

SPLIT_SIZES = (DIFF_QK_COLS, DIFF_QK_COLS, DIFF_WIDTH, DIFF_WIDTH,
               MLA_Q_RANK, MLA_KV_RANK, MLA_ROPE, MLA_WIDTH,
               D_MODEL, D_MODEL)
IN_COLS = sum(SPLIT_SIZES)

kernel_name = "hybrid_diffattn_mla_gated_block"


def rms_norm(x, gain):
    xf = x.astype(jnp.float32)
    y = xf * lax.rsqrt(jnp.mean(xf * xf, axis=-1, keepdims=True) + NORM_EPS)
    return (y * gain.astype(jnp.float32)).astype(x.dtype)


def rope_tables(positions, dim):
    inv_freq = ROPE_THETA ** (-jnp.arange(0, dim, 2, dtype=jnp.float32) / dim)
    ang = positions.astype(jnp.float32)[..., None] * inv_freq
    return jnp.cos(ang), jnp.sin(ang)


def apply_rope(x, cos, sin):
    b, s, half = cos.shape
    shape = (b,) + (1,) * (x.ndim - 3) + (s, half)
    c = cos.reshape(shape).astype(x.dtype)
    sn = sin.reshape(shape).astype(x.dtype)
    x1, x2 = x[..., :half], x[..., half:]
    return jnp.concatenate([x1 * c - x2 * sn, x2 * c + x1 * sn], axis=-1)


def causal_multimap_attention(q, k, v, map_weights, scale):
    b, h, m, s, dk = q.shape
    dv = v.shape[-1]
    nb = s // Q_BLOCK
    qb = jnp.moveaxis(q.reshape(b, h, m, nb, Q_BLOCK, dk), 3, 0)
    kpos = jnp.arange(s)
    w = map_weights.astype(jnp.float32)

    def one_block(args):
        q_blk, i = args
        qpos = i * Q_BLOCK + jnp.arange(Q_BLOCK)
        sc = jnp.einsum('bhmqd,bhmkd->bhmqk', q_blk, k).astype(jnp.float32) * scale
        sc = jnp.where(kpos[None, :] <= qpos[:, None], sc, -jnp.inf)
        p = jax.nn.softmax(sc, axis=-1)
        p = jnp.einsum('m,bhmqk->bhqk', w, p)
        return jnp.einsum('bhqk,bhkd->bhqd', p.astype(v.dtype), v)

    out = lax.map(one_block, (qb, jnp.arange(nb)))
    return jnp.moveaxis(out, 0, 2).reshape(b, h, s, dv)


def setup_inputs(seed: int = 0) -> dict:
    key = jax.random.key(seed)
    ks = jax.random.split(key, 20)
    L = DEPTH
    nrm = lambda k, shape, fan: jax.random.normal(k, shape, jnp.float32) * fan ** -0.5
    gain = lambda k, n: 1.0 + 0.05 * jax.random.normal(k, (L, n), jnp.float32)
    x = jax.random.normal(ks[0], (BATCH, SEQ, D_MODEL), jnp.float32)
    positions = jnp.broadcast_to(jnp.arange(SEQ, dtype=jnp.int32), (BATCH, SEQ))
    return {
        "x": x,
        "positions": positions,
        "norm_in": gain(ks[1], D_MODEL),
        "w_in": nrm(ks[2], (L, D_MODEL, IN_COLS), D_MODEL),
        "diff_lambda_q1": 0.1 * jax.random.normal(ks[3], (L, DIFF_HEAD_DIM), jnp.float32),
        "diff_lambda_k1": 0.1 * jax.random.normal(ks[4], (L, DIFF_HEAD_DIM), jnp.float32),
        "diff_lambda_q2": 0.1 * jax.random.normal(ks[5], (L, DIFF_HEAD_DIM), jnp.float32),
        "diff_lambda_k2": 0.1 * jax.random.normal(ks[6], (L, DIFF_HEAD_DIM), jnp.float32),
        "diff_subln": gain(ks[7], DIFF_V_DIM),
        "mla_q_norm": gain(ks[8], MLA_Q_RANK),
        "w_uq": nrm(ks[9], (L, MLA_Q_RANK, MLA_HEADS * (MLA_NOPE + MLA_ROPE)), MLA_Q_RANK),
        "mla_kv_norm": gain(ks[10], MLA_KV_RANK),
        "w_ukv": nrm(ks[11], (L, MLA_KV_RANK, MLA_HEADS * (MLA_NOPE + MLA_V)), MLA_KV_RANK),
        "w_proj_diff": nrm(ks[12], (L, DIFF_WIDTH, D_MODEL), DIFF_WIDTH),
        "w_proj_mla": nrm(ks[13], (L, MLA_WIDTH, D_MODEL), MLA_WIDTH),
        "w_out": nrm(ks[14], (L, D_MODEL, D_MODEL), D_MODEL),
        "norm_final": 1.0 + 0.05 * jax.random.normal(ks[15], (D_MODEL,), jnp.float32),
    }


def reference(x, positions, norm_in, w_in, diff_lambda_q1, diff_lambda_k1,
              diff_lambda_q2, diff_lambda_k2, diff_subln, mla_q_norm, w_uq,
              mla_kv_norm, w_ukv, w_proj_diff, w_proj_mla, w_out, norm_final):
    b, s, _ = x.shape
    cos_d, sin_d = rope_tables(positions, DIFF_HEAD_DIM)
    cos_m, sin_m = rope_tables(positions, MLA_ROPE)
    split_idx = list(np.cumsum(SPLIT_SIZES)[:-1])

    for layer in range(DEPTH):
        lambda_init = 0.8 - 0.6 * math.exp(-0.3 * layer)
        h = rms_norm(x, norm_in[layer])
        proj = h @ w_in[layer]
        (dq, dk, dv, dgate, cq, ckv, kr, mgate, g_diff, g_mla) = jnp.split(proj, split_idx, axis=-1)

        dq = dq.reshape(b, s, DIFF_HEADS, 2, DIFF_HEAD_DIM).transpose(0, 2, 3, 1, 4)
        dk = dk.reshape(b, s, DIFF_HEADS, 2, DIFF_HEAD_DIM).transpose(0, 2, 3, 1, 4)
        dv = dv.reshape(b, s, DIFF_HEADS, DIFF_V_DIM).transpose(0, 2, 1, 3)
        dq = apply_rope(dq, cos_d, sin_d)
        dk = apply_rope(dk, cos_d, sin_d)
        lam = (jnp.exp(jnp.sum(diff_lambda_q1[layer] * diff_lambda_k1[layer]))
               - jnp.exp(jnp.sum(diff_lambda_q2[layer] * diff_lambda_k2[layer]))
               + lambda_init)
        weights = jnp.stack([jnp.ones_like(lam), -lam])
        o_diff = causal_multimap_attention(dq, dk, dv, weights, DIFF_HEAD_DIM ** -0.5)
        o_diff = rms_norm(o_diff, diff_subln[layer]) * (1.0 - lambda_init)
        o_diff = o_diff.transpose(0, 2, 1, 3).reshape(b, s, DIFF_WIDTH)
        o_diff = o_diff * jax.nn.silu(dgate)

        cq = rms_norm(cq, mla_q_norm[layer])
        q = (cq @ w_uq[layer]).reshape(b, s, MLA_HEADS, MLA_NOPE + MLA_ROPE).transpose(0, 2, 1, 3)
        q_nope, q_rope = q[..., :MLA_NOPE], apply_rope(q[..., MLA_NOPE:], cos_m, sin_m)
        ckv = rms_norm(ckv, mla_kv_norm[layer])
        kv = (ckv @ w_ukv[layer]).reshape(b, s, MLA_HEADS, MLA_NOPE + MLA_V).transpose(0, 2, 1, 3)
        k_nope, mv = kv[..., :MLA_NOPE], kv[..., MLA_NOPE:]
        k_rope = apply_rope(kr[:, None], cos_m, sin_m)
        mq = jnp.concatenate([q_nope, q_rope], axis=-1)[:, :, None]
        mk = jnp.concatenate([k_nope, jnp.broadcast_to(k_rope, k_nope.shape[:-1] + (MLA_ROPE,))], axis=-1)[:, :, None]
        o_mla = causal_multimap_attention(mq, mk, mv, jnp.ones((1,), jnp.float32),
                                          (MLA_NOPE + MLA_ROPE) ** -0.5)
        o_mla = o_mla.transpose(0, 2, 1, 3).reshape(b, s, MLA_WIDTH)
        o_mla = o_mla * jax.nn.silu(mgate)

        merged = (jax.nn.sigmoid(g_diff) * (o_diff @ w_proj_diff[layer])
                  + jax.nn.sigmoid(g_mla) * (o_mla @ w_proj_mla[layer]))
        x = x + merged @ w_out[layer]

    return rms_norm(x, norm_final)
```

```cpp
#include <hip/hip_runtime.h>
#include <hip/hip_bf16.h>
#include <hip/hip_cooperative_groups.h>
#include <cstdio>
#include <cstdint>
#include <cmath>

__device__ __forceinline__ int fresh_lane() { int l; asm volatile("v_mbcnt_lo_u32_b32 %0, -1, 0\n\tv_mbcnt_hi_u32_b32 %0, -1, %0" : "=v"(l)); return l; }

namespace pg8 {
#define PG8_LAS __attribute__((address_space(3)))
typedef unsigned short bf16_t;
typedef short bf16x8 __attribute__((ext_vector_type(8)));
typedef float f32x4 __attribute__((ext_vector_type(4)));
typedef unsigned u32x4 __attribute__((ext_vector_type(4)));
constexpr int BM = 256, BK = 64, HALF = 128, HTB = HALF * BK * 2  , STAGE_BYTES = 8 * HTB, NXCD = 8, WGM = 8;

__host__ __device__ __forceinline__ int lds_byte(int r, int c) { const int st = (r >> 4) * 2 + (c >> 5), rr = r & 15, cc = c & 31, ob = rr * 64 + cc * 2; return st * 1024 + (ob ^ (((ob >> 9) & 1) << 5)); }
__host__ __device__ __forceinline__ void stage_rc(int b, int& R, int& C) { const int st = b / 1024, sb = b % 1024, swz = sb ^ (((sb >> 9) & 1) << 5); R = (st >> 1) * 16 + swz / 64; C = (st & 1) * 32 + (swz % 64) / 2; }
__host__ __device__ __forceinline__ int perm32(int rho) { const int n = rho >> 4, i = rho & 15; return 8 * (i >> 2) + 4 * n + (i & 3); }

struct Unit { int pm, pn; };
struct Gemm { const bf16_t* A; const bf16_t* Bt; int M, N, K; };

struct StaticOrder {
    int nM, nN, nwg, G, c;
    __host__ __device__ void init(int M, int N, int G_, int c_) { nM = M / BM; nN = N / BM; nwg = nM * nN; G = G_; c = c_; }
    __host__ __device__ bool next(int i, Unit& u) const {
        const long L = (long)i * G + c; if (L >= nwg) return false;
        int wgid = (int)L; { const int q = nwg / NXCD, r = nwg % NXCD, xcd = wgid % NXCD, off = wgid / NXCD; wgid = (xcd < r ? xcd * (q + 1) : r * (q + 1) + (xcd - r) * q) + off; }
        const int nig = WGM * nN, gid = wgid / nig, fm = gid * WGM, gsz = (nM - fm) < WGM ? (nM - fm) : WGM;
        u.pm = fm + ((wgid % nig) % gsz); u.pn = (wgid % nig) / gsz; return true;
    }
    __device__ __forceinline__ void a_ready(const Unit&) const {}
    __device__ __forceinline__ void done(const Unit&) const {}
};

template <class Epi, class Sched, bool ALIGN_EPI = false, bool SP2 = false>
__device__ __forceinline__ void gemm_phase(PG8_LAS unsigned char* lds, const Gemm g, const Sched& S, const Epi& E, const int wave_s) {
    const int tid_ = wave_s * 64 + fresh_lane();
    const int tid = tid_, wid = wave_s, lane = tid & 63, wr = wid >> 2, wc = wid & 3, fr = lane & 15, fq = lane >> 4;
    const int K = g.K, nt = K / BK;
    unsigned voffA[2], voffB[2];
#pragma unroll
    for (int i = 0; i < 2; ++i) { int R, C; stage_rc(tid * 16 + i * 8192, R, C); const int Rb = Epi::PERM ? ((R & ~31) + perm32(R & 31)) : R;
        voffA[i] = (unsigned)(R * K + C) * 2u; voffB[i] = (unsigned)(Rb * K + C) * 2u; }
    const size_t kstep = (size_t)(BK * 2);
    const size_t hstep = (size_t)HALF * K * 2;
    const size_t tstep = 2 * hstep;
    const unsigned ldsw = (unsigned)wid * 1024u;
    const int aoff = lds_byte(wr * 64 + fr, fq * 8), boff = lds_byte(wc * 32 + fr, fq * 8);
#define PG8_SA(b, h) (((b) * 2 + (h)) * HTB)
#define PG8_SB(b, h) ((4 + (b) * 2 + (h)) * HTB)
#define PG8_STAGE(bufoff, gbase, voff) do { _Pragma("unroll") for (int _i = 0; _i < 2; ++_i) \
        __builtin_amdgcn_global_load_lds((const unsigned*)((const char*)(gbase) + (voff)[_i]), (PG8_LAS unsigned*)(lds + (bufoff) + ldsw + _i * 8192), 16, 0, 0); } while (0)
#define PG8_LDA(dst, b, h) do { _Pragma("unroll") for (int m = 0; m < 4; ++m) _Pragma("unroll") for (int k = 0; k < 2; ++k) dst[m][k] = *(const PG8_LAS bf16x8*)(lds + PG8_SA(b, h) + aoff + m * 2048 + k * 1024); } while (0)
#define PG8_LDB(dst, b, h) do { _Pragma("unroll") for (int n = 0; n < 2; ++n) _Pragma("unroll") for (int k = 0; k < 2; ++k) dst[n][k] = *(const PG8_LAS bf16x8*)(lds + PG8_SB(b, h) + boff + n * 2048 + k * 1024); } while (0)
#define PG8_MMA(ai, bj, At, Bt) do { __builtin_amdgcn_s_setprio(1); _Pragma("unroll") for (int m = 0; m < 4; ++m) _Pragma("unroll") for (int n = 0; n < 2; ++n) _Pragma("unroll") for (int k = 0; k < 2; ++k) \
        acc[ai][bj][m][n] = __builtin_amdgcn_mfma_f32_16x16x32_bf16(Bt[n][k], At[m][k], acc[ai][bj][m][n], 0, 0, 0); __builtin_amdgcn_s_setprio(0); } while (0)
#define PG8_WAIT_V(n) asm volatile("s_waitcnt vmcnt(" #n ")" ::: "memory")
#define PG8_WAIT_L(n) asm volatile("s_waitcnt lgkmcnt(" #n ")" ::: "memory")
#define PG8_BAR __builtin_amdgcn_s_barrier()
#define PG8_SCHED __builtin_amdgcn_sched_barrier(0)
    Unit cur, nxt; int ui = 0;
    if (!S.next(0, cur)) return;
    f32x4 acc[2][2][4][2];
#pragma unroll
    for (int a = 0; a < 2; ++a)
#pragma unroll
        for (int b = 0; b < 2; ++b)
#pragma unroll
            for (int m = 0; m < 4; ++m)
#pragma unroll
                for (int n = 0; n < 2; ++n) acc[a][b][m][n] = (f32x4){0.f, 0.f, 0.f, 0.f};
    bf16x8 At[4][2], B0[2][2], B1[2][2];
    const char* cA = (const char*)g.A + (size_t)cur.pm * tstep; const char* cB = (const char*)g.Bt + (size_t)cur.pn * tstep;
    S.a_ready(cur);
    if constexpr (SP2) {
        PG8_STAGE(PG8_SB(0, 0), cB, voffB); PG8_STAGE(PG8_SB(0, 1), cB + hstep, voffB); PG8_STAGE(PG8_SA(0, 0), cA, voffA); PG8_STAGE(PG8_SA(0, 1), cA + hstep, voffA);
        if (wr == 1) PG8_BAR;
        PG8_WAIT_V(2); PG8_BAR;
        PG8_STAGE(PG8_SB(1, 0), cB + kstep, voffB); PG8_STAGE(PG8_SA(1, 0), cA + kstep, voffA); PG8_STAGE(PG8_SB(1, 1), cB + hstep + kstep, voffB);
        PG8_WAIT_V(6); PG8_BAR;
    } else {
        PG8_STAGE(PG8_SB(0, 0), cB, voffB); PG8_STAGE(PG8_SA(0, 0), cA, voffA); PG8_STAGE(PG8_SB(0, 1), cB + hstep, voffB); PG8_STAGE(PG8_SA(0, 1), cA + hstep, voffA);
        if (wr == 1) PG8_BAR;
        PG8_WAIT_V(4); PG8_BAR;
        PG8_STAGE(PG8_SB(1, 0), cB + kstep, voffB); PG8_STAGE(PG8_SA(1, 0), cA + kstep, voffA); PG8_STAGE(PG8_SB(1, 1), cB + hstep + kstep, voffB);
        PG8_WAIT_V(6); PG8_BAR;
    }
    for (;;) {
        const bool has_next = S.next(ui + 1, nxt);
        const char* nA = has_next ? (const char*)g.A + (size_t)nxt.pm * tstep : cA; const char* nB = has_next ? (const char*)g.Bt + (size_t)nxt.pn * tstep : cB;
        for (int t = 0; t < nt; t += 2) {
            const bool last = (t == nt - 2);
            const char* a1 = cA + (size_t)(t + 1) * kstep;
            const char* a2 = last ? nA : cA + (size_t)(t + 2) * kstep; const char* b2 = last ? nB : cB + (size_t)(t + 2) * kstep;
            const char* a3 = a2 + kstep; const char* b3 = b2 + kstep;
            if (last && has_next) S.a_ready(nxt);
            if constexpr (SP2) {
            PG8_LDB(B0, 0, 0); PG8_LDB(B1, 0, 1); PG8_SCHED; PG8_LDA(At, 0, 0); PG8_STAGE(PG8_SA(1, 1), a1 + hstep, voffA);
            PG8_WAIT_V(8); PG8_WAIT_L(0); PG8_BAR; PG8_MMA(0, 0, At, B0); PG8_MMA(0, 1, At, B1); PG8_BAR; PG8_SCHED;
            PG8_LDA(At, 0, 1); PG8_STAGE(PG8_SB(0, 0), b2, voffB); PG8_STAGE(PG8_SB(0, 1), b2 + hstep, voffB); PG8_STAGE(PG8_SA(0, 0), a2, voffA);
            PG8_WAIT_V(8); PG8_WAIT_L(0); PG8_BAR; PG8_MMA(1, 0, At, B0); PG8_MMA(1, 1, At, B1); PG8_BAR; PG8_SCHED;
            PG8_LDB(B0, 1, 0); PG8_LDB(B1, 1, 1); PG8_SCHED; PG8_LDA(At, 1, 0); PG8_STAGE(PG8_SA(0, 1), a2 + hstep, voffA);
            PG8_WAIT_V(8); PG8_WAIT_L(0); PG8_BAR; PG8_MMA(0, 0, At, B0); PG8_MMA(0, 1, At, B1); PG8_BAR; PG8_SCHED;
            PG8_LDA(At, 1, 1); PG8_STAGE(PG8_SB(1, 0), b3, voffB); PG8_STAGE(PG8_SB(1, 1), b3 + hstep, voffB); PG8_STAGE(PG8_SA(1, 0), a3, voffA);
            PG8_WAIT_V(8); PG8_WAIT_L(0); PG8_BAR; PG8_MMA(1, 0, At, B0); PG8_MMA(1, 1, At, B1); PG8_BAR; PG8_SCHED;
            } else {
            PG8_LDB(B0, 0, 0); PG8_SCHED; PG8_LDA(At, 0, 0); PG8_STAGE(PG8_SA(1, 1), a1 + hstep, voffA);
            PG8_WAIT_L(8); PG8_BAR; PG8_WAIT_L(0); PG8_MMA(0, 0, At, B0); PG8_BAR; PG8_SCHED;
            PG8_LDB(B1, 0, 1); PG8_STAGE(PG8_SB(0, 0), b2, voffB);
            PG8_BAR; PG8_WAIT_L(0); PG8_MMA(0, 1, At, B1); PG8_BAR;
            PG8_LDA(At, 0, 1); PG8_STAGE(PG8_SA(0, 0), a2, voffA);
            PG8_BAR; PG8_WAIT_L(0); PG8_MMA(1, 0, At, B0); PG8_BAR; PG8_SCHED;
            PG8_STAGE(PG8_SB(0, 1), b2 + hstep, voffB);
            PG8_WAIT_V(6); PG8_BAR; PG8_MMA(1, 1, At, B1); PG8_BAR;
            PG8_LDB(B0, 1, 0); PG8_SCHED; PG8_LDA(At, 1, 0); PG8_STAGE(PG8_SA(0, 1), a2 + hstep, voffA);
            PG8_WAIT_L(8); PG8_BAR; PG8_WAIT_L(0); PG8_MMA(0, 0, At, B0); PG8_BAR; PG8_SCHED;
            PG8_LDB(B1, 1, 1); PG8_STAGE(PG8_SB(1, 0), b3, voffB);
            PG8_BAR; PG8_WAIT_L(0); PG8_MMA(0, 1, At, B1); PG8_BAR;
            PG8_LDA(At, 1, 1); PG8_STAGE(PG8_SA(1, 0), a3, voffA);
            PG8_BAR; PG8_WAIT_L(0); PG8_MMA(1, 0, At, B0); PG8_BAR; PG8_SCHED;
            PG8_STAGE(PG8_SB(1, 1), b3 + hstep, voffB);
            PG8_WAIT_V(6); PG8_BAR; PG8_MMA(1, 1, At, B1); PG8_BAR;
            }
        }
        if constexpr (ALIGN_EPI) { if (wr == 0) PG8_BAR; }
        if constexpr (!Epi::AFTER_DRAIN) { E(acc, cur, wr, wc, fr, fq); S.done(cur); }
        if (!has_next) break;
#pragma unroll
        for (int a = 0; a < 2; ++a)
#pragma unroll
            for (int b = 0; b < 2; ++b)
#pragma unroll
                for (int m = 0; m < 4; ++m)
#pragma unroll
                    for (int n = 0; n < 2; ++n) acc[a][b][m][n] = (f32x4){0.f, 0.f, 0.f, 0.f};
        cur = nxt; cA = nA; cB = nB; ++ui;
        if constexpr (ALIGN_EPI) { if (wr == 1) PG8_BAR; }
    }
    PG8_WAIT_V(0);
    if constexpr (!ALIGN_EPI) { if (wr == 0) PG8_BAR; }
    PG8_BAR;
    if constexpr (Epi::AFTER_DRAIN) { E.fused(acc, cur, wr, wc, fr, fq, lds, wid, lane); S.done(cur); }
#undef PG8_SA
#undef PG8_SB
#undef PG8_STAGE
#undef PG8_LDA
#undef PG8_LDB
#undef PG8_MMA
#undef PG8_WAIT_V
#undef PG8_WAIT_L
#undef PG8_BAR
#undef PG8_SCHED
}
}

constexpr int S = 16384, DM = 1024;
constexpr int NIN = 5312, NINP = 5376;
constexpr float NORM_EPS = 1e-6f;
constexpr float LOG2E = 1.4426950408889634f;
constexpr float QSC_D = 0.125f * LOG2E;
constexpr float QSC_M = 0.07216878364870322f * LOG2E;
constexpr float LAMBDA_INIT = 0.2f;

typedef unsigned short bf16_t;
typedef short bf16x8 __attribute__((ext_vector_type(8)));
typedef float f32x4 __attribute__((ext_vector_type(4)));
typedef float f32x16 __attribute__((ext_vector_type(16)));
typedef unsigned u32x4 __attribute__((ext_vector_type(4)));
typedef short s16x4 __attribute__((ext_vector_type(4)));

constexpr size_t MiB = 1u << 20;
constexpr size_t WS_CTL = 0, CTL_ZERO_BYTES = 64 * 1024;
constexpr size_t WS_ORDER = 1 * MiB;
constexpr size_t WS_ROPE = 2 * MiB;
constexpr size_t WS_SSQQ = 6 * MiB;
constexpr size_t WS_SSQKV = 6 * MiB + 512 * 1024;
constexpr size_t WS_WIN = 8 * MiB;
constexpr size_t WS_WUQ = 19 * MiB;
constexpr size_t WS_WUKV = 20 * MiB;
constexpr size_t WS_WPD = 21 * MiB, WS_WPM = 22 * MiB;
constexpr size_t WS_WOUT = 23 * MiB;
constexpr size_t WS_H = 26 * MiB;
constexpr size_t WS_ODIFF = 26 * MiB, WS_OMLA = 42 * MiB;
constexpr size_t WS_QD = 58 * MiB, WS_KD = 74 * MiB, WS_VD = 90 * MiB, WS_SGD = 106 * MiB;
constexpr size_t WS_CQ = 122 * MiB, WS_CKV = 134 * MiB;
constexpr size_t WS_KM = 142 * MiB, WS_VM = 166 * MiB, WS_QM = 182 * MiB, WS_SGM = 206 * MiB;
constexpr size_t WS_MERGED = 58 * MiB;
constexpr size_t WS_PART = 142 * MiB;
constexpr size_t WS_END = 222 * MiB;

constexpr int CW_QHEAD = 64;
constexpr int CW_BAR = 1024;

typedef float f32x2_t __attribute__((ext_vector_type(2))); typedef __bf16 bf16x2_t __attribute__((ext_vector_type(2)));
__device__ __forceinline__ unsigned cvtpk(float lo, float hi) { f32x2_t v = {lo, hi}; bf16x2_t b = __builtin_convertvector(v, bf16x2_t); return __builtin_bit_cast(unsigned, b); }
__device__ __forceinline__ u32x4 pack8f(const float* v) { u32x4 w; w.x = cvtpk(v[0], v[1]); w.y = cvtpk(v[2], v[3]); w.z = cvtpk(v[4], v[5]); w.w = cvtpk(v[6], v[7]); return w; }
__device__ __forceinline__ float bf2f(bf16_t b) { return __uint_as_float(((unsigned)b) << 16); }
__device__ __forceinline__ float sigmoidf_(float x) { return __builtin_amdgcn_rcpf(1.0f + __builtin_amdgcn_exp2f(-x * LOG2E)); }
__device__ __forceinline__ float siluf_(float x) { return x * sigmoidf_(x); }

#define EPI_ROWS(...) _Pragma("unroll") for (int ai = 0; ai < 2; ++ai) _Pragma("unroll") for (int m = 0; m < 4; ++m) { const int row = rbase + ai * 128 + m * 16; __VA_ARGS__ if (m & 1) asm volatile("" ::: "memory"); }
#define EPI_ROWS1(...) _Pragma("unroll") for (int ai = 0; ai < 2; ++ai) _Pragma("unroll") for (int m = 0; m < 4; ++m) { const int row = rbase + ai * 128 + m * 16; __VA_ARGS__ asm volatile("" ::: "memory"); }
#define EPI_V8(dst, bj) float dst[8]; { const f32x4 a_ = acc[ai][bj][m][0], b_ = acc[ai][bj][m][1]; dst[0] = a_[0]; dst[1] = a_[1]; dst[2] = a_[2]; dst[3] = a_[3]; dst[4] = b_[0]; dst[5] = b_[1]; dst[6] = b_[2]; dst[7] = b_[3]; }

__device__ __forceinline__ void rope8(const float* __restrict__ rope, int row, int i0, const float* x1, const float* x2, float sc, float* o1, float* o2) {
    const f32x4 c0 = *(const f32x4*)(rope + (size_t)row * 32 + i0), c1 = *(const f32x4*)(rope + (size_t)row * 32 + i0 + 4);
    const f32x4 s0 = *(const f32x4*)(rope + (size_t)S * 32 + (size_t)row * 32 + i0), s1 = *(const f32x4*)(rope + (size_t)S * 32 + (size_t)row * 32 + i0 + 4);
#pragma unroll
    for (int j = 0; j < 8; ++j) { const float c = j < 4 ? c0[j & 3] : c1[j & 3], s = j < 4 ? s0[j & 3] : s1[j & 3];
        o1[j] = (x1[j] * c - x2[j] * s) * sc; o2[j] = (x2[j] * c + x1[j] * s) * sc; }
}

struct EpiG1 {
    static constexpr bool PERM = true, AFTER_DRAIN = false;
    bf16_t *Qd, *Kd, *Vd, *sgd, *cq, *ckv, *Km, *sgm, *gsd, *gsm; float *ssq_q, *ssq_kv; const float* rope;
    __device__ __forceinline__ void operator()(const f32x4 (&acc)[2][2][4][2], const pg8::Unit& u, int wr, int wc, int fr_, int fq_) const {
        const int ln_ = fresh_lane(), fr = ln_ & 15, fq = ln_ >> 4;
        const int pn = u.pn, rbase = u.pm * 256 + wr * 64 + fr, ch = wc * 32 + fq * 8;
        if (pn < 4) {
            bf16_t* base = pn < 2 ? Qd : Kd; const float sc = pn < 2 ? QSC_D : 1.0f;
            const int head = 2 * (pn & 1) + (wc >> 1), map = wc & 1, i0 = fq * 8;
            EPI_ROWS( EPI_V8(x1, 0) EPI_V8(x2, 1) float o1[8], o2[8]; rope8(rope, row, i0, x1, x2, sc, o1, o2);
                bf16_t* d = base + ((size_t)head * S + row) * 128 + map * 64 + i0; *(u32x4*)d = pack8f(o1); *(u32x4*)(d + 32) = pack8f(o2); )
        } else if (pn < 6) {
            EPI_ROWS( _Pragma("unroll") for (int bj = 0; bj < 2; ++bj) { EPI_V8(v, bj) const int head = 2 * (pn - 4) + bj;
                *(u32x4*)(Vd + ((size_t)head * S + row) * 128 + ch) = pack8f(v); } )
        } else if (pn < 8 || pn == 11 || pn == 12) {
            bf16_t* base = pn < 8 ? sgd : sgm; const int c0 = (pn < 8 ? pn - 6 : pn - 11) * 256 + ch;
            EPI_ROWS( _Pragma("unroll") for (int bj = 0; bj < 2; ++bj) { EPI_V8(v, bj) _Pragma("unroll") for (int j = 0; j < 8; ++j) v[j] = siluf_(v[j]);
                *(u32x4*)(base + (size_t)row * 512 + c0 + bj * 128) = pack8f(v); } )
        } else if (pn == 8) {
            EPI_ROWS( float ss = 0.f; _Pragma("unroll") for (int bj = 0; bj < 2; ++bj) { EPI_V8(v, bj) _Pragma("unroll") for (int j = 0; j < 8; ++j) ss += v[j] * v[j];
                *(u32x4*)(cq + (size_t)row * 384 + bj * 128 + ch) = pack8f(v); }
                ss += __shfl_xor(ss, 16); ss += __shfl_xor(ss, 32); if (fq == 0) ssq_q[(size_t)row * 4 + wc] = ss; )
        } else if (pn == 9) {
            if (wc < 3) {
                EPI_ROWS( EPI_V8(v0, 0) EPI_V8(v1, 1) float ss = 0.f; _Pragma("unroll") for (int j = 0; j < 8; ++j) ss += v0[j] * v0[j] + v1[j] * v1[j];
                    *(u32x4*)(cq + (size_t)row * 384 + 256 + ch) = pack8f(v0); if (wc == 0) *(u32x4*)(cq + (size_t)row * 384 + 352 + fq * 8) = pack8f(v1);
                    ss += __shfl_xor(ss, 16); ss += __shfl_xor(ss, 32); if (fq == 0) ssq_q[(size_t)S * 4 + (size_t)row * 4 + wc] = ss; )
            } else {
                const int i0 = fq * 8;
                EPI_ROWS( EPI_V8(x1, 0) EPI_V8(x2, 1) float o1[8], o2[8]; rope8(rope, row, i0, x1, x2, 1.0f, o1, o2); const u32x4 w1 = pack8f(o1), w2 = pack8f(o2);
                    _Pragma("unroll") for (int h = 0; h < 4; ++h) { bf16_t* d = Km + ((size_t)h * S + row) * 192 + 128 + i0; *(u32x4*)d = w1; *(u32x4*)(d + 32) = w2; } )
            }
        } else if (pn == 10) {
            EPI_ROWS( float ss = 0.f; _Pragma("unroll") for (int bj = 0; bj < 2; ++bj) { EPI_V8(v, bj) _Pragma("unroll") for (int j = 0; j < 8; ++j) ss += v[j] * v[j];
                *(u32x4*)(ckv + (size_t)row * 256 + bj * 128 + ch) = pack8f(v); }
                ss += __shfl_xor(ss, 16); ss += __shfl_xor(ss, 32); if (fq == 0) ssq_kv[(size_t)row * 4 + wc] = ss; )
        } else {
            bf16_t* base = pn < 17 ? gsd : gsm; const int c0 = (pn < 17 ? pn - 13 : pn - 17) * 256 + ch;
            EPI_ROWS( _Pragma("unroll") for (int bj = 0; bj < 2; ++bj) { EPI_V8(v, bj) _Pragma("unroll") for (int j = 0; j < 8; ++j) v[j] = sigmoidf_(v[j]);
                *(u32x4*)(base + (size_t)row * 1024 + c0 + bj * 128) = pack8f(v); } )
        }
    }
};

struct EpiQ {
    static constexpr bool PERM = true, AFTER_DRAIN = false;
    bf16_t* Qm; const float* ssq_q; const float* rope;
    __device__ __forceinline__ void operator()(const f32x4 (&acc)[2][2][4][2], const pg8::Unit& u, int wr, int wc, int fr_, int fq_) const {
        const int ln_ = fresh_lane(), fr = ln_ & 15, fq = ln_ >> 4;
        const int pn = u.pn, rbase = u.pm * 256 + wr * 64 + fr, ch = wc * 32 + fq * 8;
        EPI_ROWS1(
            const f32x4 sa = *(const f32x4*)(ssq_q + (size_t)row * 4), sb = *(const f32x4*)(ssq_q + (size_t)S * 4 + (size_t)row * 4);
            const float rstd = __builtin_amdgcn_rsqf(((sa[0] + sa[1]) + (sa[2] + sa[3]) + (sb[0] + sb[1]) + sb[2]) * (1.0f / 384.0f) + NORM_EPS);
            if (pn == 0) { EPI_V8(x1, 0) EPI_V8(x2, 1) float o1[8], o2[8]; rope8(rope, row, fq * 8, x1, x2, rstd * QSC_M, o1, o2);
                bf16_t* d = Qm + ((size_t)wc * S + row) * 192 + 128 + fq * 8; *(u32x4*)d = pack8f(o1); *(u32x4*)(d + 32) = pack8f(o2); }
            else { _Pragma("unroll") for (int bj = 0; bj < 2; ++bj) { EPI_V8(v, bj) _Pragma("unroll") for (int j = 0; j < 8; ++j) v[j] *= rstd * QSC_M;
                const int head = 2 * (pn - 1) + bj; *(u32x4*)(Qm + ((size_t)head * S + row) * 192 + ch) = pack8f(v); } } )
    }
};
struct EpiKV {
    static constexpr bool PERM = true, AFTER_DRAIN = false;
    bf16_t *Km, *Vm; const float* ssq_kv;
    __device__ __forceinline__ void operator()(const f32x4 (&acc)[2][2][4][2], const pg8::Unit& u, int wr, int wc, int fr_, int fq_) const {
        const int ln_ = fresh_lane(), fr = ln_ & 15, fq = ln_ >> 4;
        const int head = u.pn, rbase = u.pm * 256 + wr * 64 + fr, ch = wc * 32 + fq * 8;
        EPI_ROWS1(
            const f32x4 sa = *(const f32x4*)(ssq_kv + (size_t)row * 4);
            const float rstd = __builtin_amdgcn_rsqf(((sa[0] + sa[1]) + (sa[2] + sa[3])) * (1.0f / 256.0f) + NORM_EPS);
            { EPI_V8(v, 0) _Pragma("unroll") for (int j = 0; j < 8; ++j) v[j] *= rstd; *(u32x4*)(Km + ((size_t)head * S + row) * 192 + ch) = pack8f(v); }
            { EPI_V8(v, 1) _Pragma("unroll") for (int j = 0; j < 8; ++j) v[j] *= rstd; *(u32x4*)(Vm + ((size_t)head * S + row) * 128 + ch) = pack8f(v); } )
    }
};
struct EpiPA {
    static constexpr bool PERM = true, AFTER_DRAIN = false;
    const bf16_t* gs; float* part;
    __device__ __forceinline__ void operator()(const f32x4 (&acc)[2][2][4][2], const pg8::Unit& u, int wr, int wc, int fr_, int fq_) const {
        const int ln_ = fresh_lane(), fr = ln_ & 15, fq = ln_ >> 4;
        const int rbase = u.pm * 256 + wr * 64 + fr, c0 = u.pn * 256 + wc * 32 + fq * 8;
        EPI_ROWS( _Pragma("unroll") for (int bj = 0; bj < 2; ++bj) { EPI_V8(v, bj) const size_t off = (size_t)row * 1024 + c0 + bj * 128;
            const bf16x8 g = *(const bf16x8*)(gs + off); _Pragma("unroll") for (int j = 0; j < 8; ++j) v[j] *= bf2f((bf16_t)g[j]);
            *(f32x4*)(part + off) = (f32x4){v[0], v[1], v[2], v[3]}; *(f32x4*)(part + off + 4) = (f32x4){v[4], v[5], v[6], v[7]}; } )
    }
};
struct EpiPB {
    static constexpr bool PERM = true, AFTER_DRAIN = false;
    const bf16_t* gs; const float* part; bf16_t* merged;
    __device__ __forceinline__ void operator()(const f32x4 (&acc)[2][2][4][2], const pg8::Unit& u, int wr, int wc, int fr_, int fq_) const {
        const int ln_ = fresh_lane(), fr = ln_ & 15, fq = ln_ >> 4;
        const int rbase = u.pm * 256 + wr * 64 + fr, c0 = u.pn * 256 + wc * 32 + fq * 8;
        EPI_ROWS( _Pragma("unroll") for (int bj = 0; bj < 2; ++bj) { EPI_V8(v, bj) const size_t off = (size_t)row * 1024 + c0 + bj * 128;
            const bf16x8 g = *(const bf16x8*)(gs + off); const f32x4 p0 = *(const f32x4*)(part + off), p1 = *(const f32x4*)(part + off + 4);
            _Pragma("unroll") for (int j = 0; j < 8; ++j) v[j] = v[j] * bf2f((bf16_t)g[j]) + (j < 4 ? p0[j & 3] : p1[j & 3]);
            *(u32x4*)(merged + off) = pack8f(v); } )
    }
};
struct EpiOut {
    static constexpr bool PERM = true, AFTER_DRAIN = false;
    const float* x; float* y;
    __device__ __forceinline__ void operator()(const f32x4 (&acc)[2][2][4][2], const pg8::Unit& u, int wr, int wc, int fr_, int fq_) const {
        const int ln_ = fresh_lane(), fr = ln_ & 15, fq = ln_ >> 4;
        const int rbase = u.pm * 256 + wr * 64 + fr, c0 = u.pn * 256 + wc * 32 + fq * 8;
        EPI_ROWS( _Pragma("unroll") for (int bj = 0; bj < 2; ++bj) { const size_t off = (size_t)row * 1024 + c0 + bj * 128;
            *(f32x4*)(y + off) = *(const f32x4*)(x + off) + acc[ai][bj][m][0]; *(f32x4*)(y + off + 4) = *(const f32x4*)(x + off + 4) + acc[ai][bj][m][1]; } )
    }
};

namespace att {
#define SBAR() __builtin_amdgcn_sched_barrier(0)
constexpr int SHM_V = 64 * 128 * 2;
#ifndef MLA_NQR
#define MLA_NQR 12
#endif
constexpr int LDS_V = 0, LDS_K = 2 * SHM_V, LDS_WS = LDS_K + 2 * 64 * 192 * 2  , LDS_QST = LDS_WS + 8 * 256, LDS_END = LDS_QST + 8 * (12 - MLA_NQR) * 1024;
constexpr int XP = 132;
constexpr float THR = 8.f;
__device__ __forceinline__ int v_st(int k, int c) { const int kk = (k & ~0xC) | ((k & 4) << 1) | ((k & 8) >> 1); return ((kk >> 3) * 4 + (c >> 5)) * 512 + ((kk & 7) * 32 + (c & 31)) * 2; }
__device__ __forceinline__ int v_rd_base(int lane) { return ((lane & 3) << 3) | (((lane >> 2) & 3) << 6) | (((lane >> 4) & 1) << 5) | (((lane >> 5) & 1) << 8); }
constexpr int v_rd_off(int d0, int ks, int half) { return d0 * 512 + ks * 4096 + half * 2048; }
__device__ __forceinline__ int crow(int r, int hi) { return (r & 3) + 8 * (r >> 2) + 4 * hi; }
__device__ __forceinline__ void mask_tile(f32x16& p0, f32x16& p1, int dq) {
    const float NEG = -__builtin_inff();
#pragma unroll
    for (int r = 0; r < 16; ++r) { const int c = (r & 3) + 8 * (r >> 2); if (dq - c < 0) p0[r] = NEG; if (dq - c - 32 < 0) p1[r] = NEG; }
}
__device__ __forceinline__ void partialSM(f32x16& p0, f32x16& p1, float& m_reg, float& alpha) {
    float pmax = p0[0];
#pragma unroll
    for (int r = 1; r < 16; ++r) pmax = fmaxf(pmax, p0[r]);
#pragma unroll
    for (int r = 0; r < 16; ++r) pmax = fmaxf(pmax, p1[r]);
    { auto rr = __builtin_amdgcn_permlane32_swap(__float_as_uint(pmax), __float_as_uint(pmax), false, false);
      pmax = fmaxf(__uint_as_float(rr[0]), __uint_as_float(rr[1])); }
    float mn;
    if (__builtin_expect(__all(pmax - m_reg <= THR), 1)) { mn = m_reg; alpha = 1.f; }
    else { mn = fmaxf(m_reg, pmax); alpha = __builtin_amdgcn_exp2f(m_reg - mn); m_reg = mn; }
#pragma unroll
    for (int r = 0; r < 16; ++r) p0[r] = p0[r] - mn;
#pragma unroll
    for (int r = 0; r < 16; ++r) p1[r] = p1[r] - mn;
#pragma unroll
    for (int r = 0; r < 16; ++r) p0[r] = __builtin_amdgcn_exp2f(p0[r]);
}
__device__ __forceinline__ void finishSM(f32x16& p0, f32x16& p1, float alpha, float& l_reg, bf16x8& pa0, bf16x8& pa1, bf16x8& pa2, bf16x8& pa3) {
#pragma unroll
    for (int r = 0; r < 16; ++r) p1[r] = __builtin_amdgcn_exp2f(p1[r]);
    float ps = 0;
#pragma unroll
    for (int r = 0; r < 16; ++r) ps += p0[r];
#pragma unroll
    for (int r = 0; r < 16; ++r) ps += p1[r];
    { auto rr = __builtin_amdgcn_permlane32_swap(__float_as_uint(ps), __float_as_uint(ps), false, false);
      ps = __uint_as_float(rr[0]) + __uint_as_float(rr[1]); }
    l_reg = l_reg * alpha + ps;
#define PK4(P, B_, OUT) do { unsigned a0 = cvtpk(P[B_+0], P[B_+1]), a1 = cvtpk(P[B_+2], P[B_+3]);                          \
        unsigned b0 = cvtpk(P[B_+4], P[B_+5]), b1 = cvtpk(P[B_+6], P[B_+7]);                                             \
        auto r0 = __builtin_amdgcn_permlane32_swap(a0, b0, false, false); auto r1 = __builtin_amdgcn_permlane32_swap(a1, b1, false, false); \
        u32x4 w = {r0[0], r1[0], r0[1], r1[1]}; OUT = *reinterpret_cast<bf16x8*>(&w); } while (0)
    PK4(p0, 0, pa0); PK4(p0, 8, pa1); PK4(p1, 0, pa2); PK4(p1, 8, pa3);
#undef PK4
}
template <int NK, int KROWB, int NQR>
__device__ __forceinline__ void qkt(f32x16& p0, f32x16& p1, const char* Kb, int r32, int hi, const bf16x8* qr, const char* qst) {
    p0 = f32x16{}; p1 = f32x16{};
    const char* kb[4];
#pragma unroll
    for (int dd = 0; dd < 4; ++dd) kb[dd] = Kb + r32 * KROWB + (((dd * 16 + hi * 8) * 2) ^ ((r32 & 7) << 4));
#pragma unroll
    for (int d0 = 0; d0 < NK; ++d0) { const char* a = kb[d0 & 3] + (d0 >> 2) * 128;
#ifdef QKT_SB
        if (NK > 4 && d0 > 0 && (d0 % QKT_SB) == 0) SBAR();
#endif
        bf16x8 b0 = *reinterpret_cast<const bf16x8*>(a);
        bf16x8 b1 = *reinterpret_cast<const bf16x8*>(a + 32 * KROWB);
        bf16x8 qf; if (d0 < NQR) qf = qr[d0]; else qf = *reinterpret_cast<const bf16x8*>(qst + (d0 - NQR) * 1024);
        p0 = __builtin_amdgcn_mfma_f32_32x32x16_bf16(b0, qf, p0, 0, 0, 0);
        p1 = __builtin_amdgcn_mfma_f32_32x32x16_bf16(b1, qf, p1, 0, 0, 0); }
}
template <int VB>
__device__ __forceinline__ void pv_tile(f32x16* o, int vb0, bf16x8 pa0, bf16x8 pa1, bf16x8 pa2, bf16x8 pa3) {
#define TRRD(dst, off) asm volatile("ds_read_b64_tr_b16 %0, %1 offset:%2" : "=&v"(dst) : "v"(vb0), "i"(off) : "memory")
#define PV_D0(d0) do { s16x4 l0, l1, l2, l3, h0, h1, h2, h3; constexpr int b_ = VB * SHM_V + v_rd_off(d0, 0, 0); \
        TRRD(l0, b_); TRRD(h0, b_ + 2048); TRRD(l1, b_ + 4096); TRRD(h1, b_ + 6144); TRRD(l2, b_ + 8192); TRRD(h2, b_ + 10240); TRRD(l3, b_ + 12288); TRRD(h3, b_ + 14336); \
        asm volatile("s_waitcnt lgkmcnt(0)" ::: "memory"); SBAR();   \
        o[d0] = __builtin_amdgcn_mfma_f32_32x32x16_bf16(pa0, (bf16x8){l0[0], l0[1], l0[2], l0[3], h0[0], h0[1], h0[2], h0[3]}, o[d0], 0, 0, 0);   \
        o[d0] = __builtin_amdgcn_mfma_f32_32x32x16_bf16(pa1, (bf16x8){l1[0], l1[1], l1[2], l1[3], h1[0], h1[1], h1[2], h1[3]}, o[d0], 0, 0, 0);   \
        o[d0] = __builtin_amdgcn_mfma_f32_32x32x16_bf16(pa2, (bf16x8){l2[0], l2[1], l2[2], l2[3], h2[0], h2[1], h2[2], h2[3]}, o[d0], 0, 0, 0);   \
        o[d0] = __builtin_amdgcn_mfma_f32_32x32x16_bf16(pa3, (bf16x8){l3[0], l3[1], l3[2], l3[3], h3[0], h3[1], h3[2], h3[3]}, o[d0], 0, 0, 0); } while (0)
    PV_D0(0); PV_D0(1); PV_D0(2); PV_D0(3);
#undef PV_D0
#undef TRRD
}

struct DiffEpi { const bf16_t* sgd; const float* subln; bf16_t* out; float lam; };
struct MlaEpi { const bf16_t* sgm; bf16_t* out; };

template <bool MLA, class Epi>
__device__ __forceinline__ void attn_unit(char* lds, const bf16_t* __restrict__ Qh, const bf16_t* __restrict__ Kh, const bf16_t* __restrict__ Vh, int P0, int head, const Epi& E, const int wave_s) {
    constexpr int KD = MLA ? 192 : 128, NK = MLA ? 12 : 4, NQR = MLA ? MLA_NQR : 4, QB = MLA ? 256 : 128, KROWB = KD * 2, SHM_K = 64 * KROWB, CPR = KD / 8, NCH = (64 * CPR) / 512;
    const int tid = wave_s * 64 + fresh_lane(), wid = wave_s, lane = tid & 63, r32 = lane & 31, hi = lane >> 5;
    const int map = MLA ? 0 : (wid >> 2), wrow = MLA ? wid * 32 : (wid & 3) * 32;
    const int NT = (P0 + QB) / 64;
    const int qlo = P0 + wrow, qm = qlo + r32 - 4 * hi;
    char* V_lds = lds + LDS_V; char* K_lds = lds + LDS_K;
    float* ws = (float*)(lds + LDS_WS) + wid * 64; float* li_l = ws; float* al_l = ws + 32;
    float m_reg = -1e30f, l_reg = 0.f; f32x16 o[4] = {};
    int ksrc[NCH], kdst[NCH];
#pragma unroll
    for (int j = 0; j < NCH; ++j) { const int c = tid + 512 * j, row = c / CPR, chk = c % CPR; ksrc[j] = row * KD + chk * 8; kdst[j] = row * KROWB + ((chk * 16) ^ ((row & 7) << 4)); }
    const int sr = tid >> 4, sc = (tid & 15) * 8, vst0 = v_st(sr, sc), vst1 = v_st(32 + sr, sc);
    const int vb0 = (int)(uintptr_t)V_lds + v_rd_base(lane);
    bf16x8 st_k[NCH], st_v0, st_v1;
#define SLOAD(t) do { const bf16_t* kp_ = Kh + (size_t)(t) * 64 * KD; const bf16_t* vp_ = Vh + (size_t)(t) * 64 * 128;                              \
        st_v0 = *(const bf16x8*)(vp_ + sr * 128 + sc); st_v1 = *(const bf16x8*)(vp_ + (32 + sr) * 128 + sc);                                         \
        _Pragma("unroll") for (int j = 0; j < NCH; ++j) st_k[j] = *(const bf16x8*)(kp_ + ksrc[j]); } while (0)
#define SWRITE(bf) do { *(bf16x8*)(V_lds + (bf) * SHM_V + vst0) = st_v0; *(bf16x8*)(V_lds + (bf) * SHM_V + vst1) = st_v1;                           \
        _Pragma("unroll") for (int j = 0; j < NCH; ++j) *(bf16x8*)(K_lds + (bf) * SHM_K + kdst[j]) = st_k[j]; } while (0)
#define VMW() asm volatile("s_waitcnt vmcnt(0)" ::: "memory")
#define RESC(a) do { if (__any((a) < 1.f)) { if (hi == 0) al_l[r32] = (a); asm volatile("s_waitcnt lgkmcnt(0)" ::: "memory");              \
                     _Pragma("unroll") for (int d_ = 0; d_ < 4; ++d_) _Pragma("unroll") for (int r = 0; r < 16; ++r) o[d_][r] *= al_l[crow(r, hi)]; } } while (0)
#define MASKT(PX0, PX1, t) do { const int kb_ = (t) * 64; if (kb_ + 63 > qlo) mask_tile(PX0, PX1, qm - kb_); } while (0)
#define KBUF(b) (K_lds + (b) * SHM_K + map * 128)
    bf16x8 qr[NQR]; char* qst = lds + LDS_QST + wid * ((12 - MLA_NQR) * 1024) + lane * 16;
    { const bf16_t* qp = Qh + (size_t)(qlo + r32) * KD + map * 64 + hi * 8;
#pragma unroll
      for (int d0 = 0; d0 < NK; ++d0) { const bf16x8 qv = *(const bf16x8*)(qp + d0 * 16); if (d0 < NQR) qr[d0] = qv; else *(bf16x8*)(qst + (d0 - NQR) * 1024) = qv; } }
    f32x16 pA0, pA1; float alA; bf16x8 pa0, pa1, pa2, pa3;
  if constexpr (MLA) {
    SLOAD(0); VMW(); SWRITE(0);
    __syncthreads();
#define STEP1(t, B) do {                                                                                                       \
        if ((t) + 1 < NT) { SLOAD((t) + 1); SBAR(); }                                                                          \
        qkt<NK, KROWB, NQR>(pA0, pA1, KBUF(B), r32, hi, qr, qst);                                                              \
        MASKT(pA0, pA1, (t)); partialSM(pA0, pA1, m_reg, alA); RESC(alA);                                                      \
        finishSM(pA0, pA1, alA, l_reg, pa0, pa1, pa2, pa3); SBAR();                                                            \
        pv_tile<B>(o, vb0, pa0, pa1, pa2, pa3);                                                                                \
        if ((t) + 1 < NT) { VMW(); SWRITE(1 - (B)); }                                                                          \
        __syncthreads(); } while (0)
    for (int t = 0; t < NT; t += 2) { STEP1(t, 0); STEP1(t + 1, 1); }
#undef STEP1
  } else {
    f32x16 pB0, pB1; float alB;
    SLOAD(0); VMW(); SWRITE(0); SBAR();
    SLOAD(1);
    __syncthreads();
    qkt<NK, KROWB, NQR>(pA0, pA1, KBUF(0), r32, hi, qr, qst);
    MASKT(pA0, pA1, 0); partialSM(pA0, pA1, m_reg, alA);
    VMW(); SWRITE(1);
    __syncthreads();
#define HALF_STEP(PX0, PX1, alX, PY0, PY1, alY, t, KB, VB) do {                                                              \
        SBAR(); qkt<NK, KROWB, NQR>(PX0, PX1, KBUF(KB), r32, hi, qr, qst);                                                     \
        finishSM(PY0, PY1, alY, l_reg, pa0, pa1, pa2, pa3); SBAR();                                                            \
        if ((t) + 1 < NT) { SLOAD((t) + 1); SBAR(); }                                                                          \
        pv_tile<VB>(o, vb0, pa0, pa1, pa2, pa3); MASKT(PX0, PX1, (t)); partialSM(PX0, PX1, m_reg, alX);                       \
        __syncthreads();                                                                                                       \
        if ((t) + 1 < NT) { VMW(); SWRITE(VB); }                                                                               \
        RESC(alX); __syncthreads(); } while (0)
    int t = 1;
    for (; t + 1 < NT; t += 2) {
        HALF_STEP(pB0, pB1, alB, pA0, pA1, alA, t, 1, 0);
        HALF_STEP(pA0, pA1, alA, pB0, pB1, alB, t + 1, 0, 1);
    }
#undef HALF_STEP
    SBAR(); qkt<NK, KROWB, NQR>(pB0, pB1, KBUF(1), r32, hi, qr, qst); SBAR();
    finishSM(pA0, pA1, alA, l_reg, pa0, pa1, pa2, pa3); SBAR();
    pv_tile<0>(o, vb0, pa0, pa1, pa2, pa3);
    MASKT(pB0, pB1, NT - 1); partialSM(pB0, pB1, m_reg, alB); RESC(alB);
    finishSM(pB0, pB1, alB, l_reg, pa0, pa1, pa2, pa3); SBAR(); pv_tile<1>(o, vb0, pa0, pa1, pa2, pa3);
  }
    if (hi == 0) li_l[r32] = l_reg; asm volatile("s_waitcnt lgkmcnt(0)" ::: "memory");
    float rli[16];
#pragma unroll
    for (int r = 0; r < 16; ++r) rli[r] = __builtin_amdgcn_rcpf(li_l[crow(r, hi)]);
    if constexpr (MLA) {
#pragma unroll
        for (int r = 0; r < 16; ++r) { const size_t g0 = (size_t)(qlo + crow(r, hi)) * 512 + head * 128 + r32;
#pragma unroll
            for (int d0 = 0; d0 < 4; ++d0) { const float v = o[d0][r] * rli[r] * bf2f(E.sgm[g0 + d0 * 32]); const float vn = __shfl_xor(v, 1);
                if ((r32 & 1) == 0) *(unsigned*)(E.out + g0 + d0 * 32) = cvtpk(v, vn); } }
        __syncthreads();
    } else {
        float* X = (float*)lds;
        __syncthreads();
        if (map == 1) {
#pragma unroll
            for (int r = 0; r < 16; ++r)
#pragma unroll
                for (int d0 = 0; d0 < 4; ++d0) X[(wrow + crow(r, hi)) * XP + d0 * 32 + r32] = E.lam * o[d0][r] * rli[r];
        }
        __syncthreads();
        if (map == 0) {
            float ssq[16];
#pragma unroll
            for (int r = 0; r < 16; ++r) { float s = 0.f;
#pragma unroll
                for (int d0 = 0; d0 < 4; ++d0) { const float v = o[d0][r] * rli[r] - X[(wrow + crow(r, hi)) * XP + d0 * 32 + r32]; o[d0][r] = v; s += v * v; }
                ssq[r] = s; }
#pragma unroll
            for (int off = 1; off < 32; off <<= 1)
#pragma unroll
                for (int r = 0; r < 16; ++r) ssq[r] += __shfl_xor(ssq[r], off);
            float gl[4];
#pragma unroll
            for (int d0 = 0; d0 < 4; ++d0) gl[d0] = E.subln[d0 * 32 + r32] * (1.0f - LAMBDA_INIT);
#pragma unroll
            for (int r = 0; r < 16; ++r) { const float rstd = __builtin_amdgcn_rsqf(ssq[r] * (1.0f / 128.0f) + NORM_EPS);
                const size_t g0 = (size_t)(qlo + crow(r, hi)) * 512 + head * 128 + r32;
#pragma unroll
                for (int d0 = 0; d0 < 4; ++d0) { const float v = o[d0][r] * rstd * gl[d0] * bf2f(E.sgd[g0 + d0 * 32]); const float vn = __shfl_xor(v, 1);
                    if ((r32 & 1) == 0) *(unsigned*)(E.out + g0 + d0 * 32) = cvtpk(v, vn); } }
        }
        __syncthreads();
    }
#undef SLOAD
#undef SWRITE
#undef VMW
#undef RESC
#undef MASKT
#undef KBUF
}
#undef SBAR
}

#ifndef N_LAUNCHES
#define N_LAUNCHES 1
#endif
#ifndef STATIC_QUEUE
#define STATIC_QUEUE 1
#endif
#ifndef USE_CG_SYNC
#define USE_CG_SYNC 0
#endif
constexpr int NWAVES = 8;
constexpr int RING_BYTES = 131072;
constexpr int LDSCTL_OFF = RING_BYTES, MISC_OFF = LDSCTL_OFF + 320;
constexpr int LDS_BYTES = 147456;
static_assert(att::LDS_END <= RING_BYTES && MISC_OFF + 128 <= LDS_BYTES, "LDS map");

#define GAS __attribute__((address_space(1)))
#define LAS __attribute__((address_space(3)))
typedef GAS unsigned gu32;
#define RLX_AGENT __ATOMIC_RELAXED, __HIP_MEMORY_SCOPE_AGENT
#define LDS_WAIT() asm volatile("s_waitcnt lgkmcnt(0)" ::: "memory")

#define XB_TMO      128
#define XB_XCNT(j)  (256  + 64 * (j))
#define XB_XSUB(j)  (1280 + 64 * (j))
#define XB_XGEN(j)  (2304 + 64 * (j))
#define XB_TOP      3328
#define XB_TOPGEN   3392
#define XCD_BAR_WORDS 3456
#define XB_SPIN_CAP (1u << 18)
__device__ __forceinline__ unsigned xb_ld(unsigned* p)              { return __hip_atomic_load(p, __ATOMIC_RELAXED, __HIP_MEMORY_SCOPE_AGENT); }
__device__ __forceinline__ unsigned xb_add(unsigned* p, unsigned v) { return __hip_atomic_fetch_add(p, v, __ATOMIC_RELAXED, __HIP_MEMORY_SCOPE_AGENT); }
__device__ __forceinline__ unsigned xb_xcc_id() { return (unsigned)__builtin_amdgcn_s_getreg((3 << 11) | 20) & 0xFu; }
#define XB_SPIN(cond, bar) do { unsigned _sp = 0; while (cond) { __builtin_amdgcn_s_sleep(1); \
    if ((++_sp & 255u) == 0u) { if (xb_ld(&(bar)[XB_TMO])) break; if (_sp > XB_SPIN_CAP) { atomicAdd(&(bar)[XB_TMO], 1u); break; } } } } while (0)
struct XcdBarrier { unsigned* bar; unsigned x; volatile LAS unsigned* st; };
__device__ __forceinline__ XcdBarrier xcd_barrier_post(unsigned* bar, volatile LAS unsigned* st, bool t0) {
    XcdBarrier b; b.bar = bar; b.x = xb_xcc_id(); b.st = st;
    if (t0) (void)xb_add(&bar[XB_XCNT(b.x)], 1u);
    return b;
}
__device__ __forceinline__ void xcd_barrier_complete(unsigned* bar, unsigned x, unsigned& nloc, unsigned& nx) {
    const unsigned G = gridDim.x * gridDim.y * gridDim.z;
    unsigned sum, cnt, mine, sp = 0u;
    for (;;) {
        sum = 0u; cnt = 0u; mine = 0u;
#pragma unroll
        for (unsigned j = 0; j < 16; ++j) { const unsigned c = xb_ld(&bar[XB_XCNT(j)]); sum += c; cnt += (c > 0u) ? 1u : 0u; mine = (j == x) ? c : mine; }
        if (sum == G) break;
        __builtin_amdgcn_s_sleep(1);
        if ((++sp & 255u) == 0u) { if (xb_ld(&bar[XB_TMO])) break; if (sp > XB_SPIN_CAP) { atomicAdd(&bar[XB_TMO], 1u); break; } }
    }
    nloc = mine > 0u ? mine : 1u; nx = cnt > 0u ? cnt : 1u;
}
__device__ __forceinline__ void xcd_barrier(const XcdBarrier& b, const int wave_s) {
    asm volatile("s_waitcnt vmcnt(0)" ::: "memory");
    __syncthreads();
    if (wave_s == 0 && fresh_lane() == 0) {
        unsigned* bar = b.bar;
        __builtin_amdgcn_s_waitcnt(0);
        unsigned nloc = b.st[0], nx = b.st[1];
        if (nloc == 0u) { xcd_barrier_complete(bar, b.x, nloc, nx); b.st[0] = nloc; b.st[1] = nx; }
        const unsigned old = xb_add(&bar[XB_XSUB(b.x)], 1u);
        const unsigned gen = old / nloc;
        if (old + 1u == (gen + 1u) * nloc) {
            __builtin_amdgcn_fence(__ATOMIC_RELEASE, "agent");
            asm volatile("s_waitcnt vmcnt(0)" ::: "memory");
            const unsigned og = xb_add(&bar[XB_TOP], 1u);
            const unsigned tg = og / nx;
            if (og + 1u == (tg + 1u) * nx) xb_add(&bar[XB_TOPGEN], 1u);
            else XB_SPIN(xb_ld(&bar[XB_TOPGEN]) == tg, bar);
            __builtin_amdgcn_fence(__ATOMIC_ACQUIRE, "agent");
            xb_add(&bar[XB_XGEN(b.x)], 1u);
            asm volatile("s_waitcnt vmcnt(0)" ::: "memory");
        } else {
            XB_SPIN(xb_ld(&bar[XB_XGEN(b.x)]) == gen, bar);
            __builtin_amdgcn_fence(__ATOMIC_ACQUIRE, "agent");
            asm volatile("s_waitcnt vmcnt(0)" ::: "memory");
        }
    }
    __syncthreads();
}

__device__ __forceinline__ float wave_sum(float v) {
#pragma unroll
    for (int o = 1; o < 64; o <<= 1) v += __shfl_xor(v, o);
    return v;
}
__host__ __device__ inline int win_logical32(int p0) {
    const int pn = p0 >> 8, pl = p0 & 255;
    if (pn < 4) { const int half = pl >> 7, g = (pl & 127) >> 5, head = 2 * (pn & 1) + (g >> 1), map = g & 1; return (pn < 2 ? 0 : 512) + head * 128 + map * 64 + half * 32; }
    if (pn < 8) return 1024 + (p0 - 4 * 256);
    if (pn == 8) return 2048 + pl;
    if (pn == 9) { if (pl < 96) return 2048 + 256 + pl; if (pl < 128) return 2688; if (pl < 160) return 2048 + 352; if (pl < 224) return -1; return 2688 + 32; }
    if (pn == 10) return 2432 + pl;
    return 2752 + (p0 - 11 * 256);
}
__host__ __device__ inline int wuq_logical32(int p0) {
    if (p0 < 256) { const int half = p0 >> 7, head = (p0 & 127) >> 5; return head * 192 + 128 + half * 32; }
    const int pl = p0 - 256, head = pl >> 7; return head * 192 + (pl & 127);
}
__device__ __forceinline__ void p0_transpose_item(const float* W, int K, int N, bf16_t* WT, int k0, int p0, int lsrc, const float* gain, LAS float* scr, int lane) {
#pragma unroll 8
    for (int i = 0; i < 32; ++i) { const int kk = 2 * i + (lane >> 5);
        float v = 0.f; if (lsrc >= 0) { v = W[(size_t)(k0 + kk) * N + lsrc + (lane & 31)]; if (gain) v *= gain[k0 + kk]; }
        scr[kk * 33 + (lane & 31)] = v; }
    LDS_WAIT(); asm volatile("" ::: "memory");
    const int c = lane & 7;
#pragma unroll
    for (int j = 0; j < 4; ++j) { const int n = (lane >> 3) + 8 * j; const LAS float* s = scr + (8 * c) * 33 + n;
        u32x4 o; o.x = cvtpk(s[0 * 33], s[1 * 33]); o.y = cvtpk(s[2 * 33], s[3 * 33]); o.z = cvtpk(s[4 * 33], s[5 * 33]); o.w = cvtpk(s[6 * 33], s[7 * 33]);
        *(u32x4*)(WT + (size_t)(p0 + n) * K + k0 + 8 * c) = o; }
    LDS_WAIT(); asm volatile("" ::: "memory");
}

struct Args { const float* x; const int* pos; const float* norm_in; const float* w_in; const float* lq1; const float* lk1; const float* lq2; const float* lk2;
              const float* subln; const float* qnorm; const float* w_uq; const float* kvnorm; const float* w_ukv; const float* wpd; const float* wpm; const float* w_out;
              const float* norm_final; float* out; unsigned char* ws; int ph_lo, ph_hi; };

constexpr int NITEMS_D = 512, NITEMS_M = 256, NITEMS = NITEMS_D + NITEMS_M;
__device__ __forceinline__ int item_cost(int e) { if (e < NITEMS_D) return (2 * ((e >> 2) + 1) + 2) * 10; const int j = (e - NITEMS_D) >> 2; return (4 * (j + 1) + 2) * 17; }

__global__ void __launch_bounds__(NWAVES * 64, 2) hybrid_fwd(Args a_unused) {
    extern __shared__ __attribute__((aligned(16))) unsigned char lds[];
    LAS unsigned char* ldsl = (LAS unsigned char*)lds;
    volatile LAS unsigned* MISC = (volatile LAS unsigned*)(ldsl + MISC_OFF);
    const int G = gridDim.x, bx = blockIdx.x;
    const int wave_s = __builtin_amdgcn_readfirstlane(threadIdx.x >> 6);
#define TID() (wave_s * 64 + fresh_lane())
    typedef const Args __attribute__((address_space(4)))* KArgP;
    const KArgP kargs = (KArgP)__builtin_amdgcn_kernarg_segment_ptr();
#define KARG() ({ KArgP p_ = kargs; asm volatile("" : "+s"(p_)); p_; })
#define WSP(T, off) ((T*)(ws + (off)))
    const int ph_lo = kargs->ph_lo, ph_hi = kargs->ph_hi;
#define IN(k) (ph_lo <= (k) && (k) < ph_hi)
#define SEAM(k) do { if (IN(k) && IN((k) + 1)) GRID_BAR(); } while (0)
    {
        for (int u = TID(); u < (LDS_BYTES - LDSCTL_OFF) / 4; u += NWAVES * 64) ((LAS unsigned*)(ldsl + LDSCTL_OFF))[u] = 0u;
        __syncthreads();
    }
#if USE_CG_SYNC
    cooperative_groups::grid_group cgrid = cooperative_groups::this_grid();
#define GRID_BAR() cgrid.sync()
#else
    XcdBarrier bar;
    { const KArgP A = KARG(); bar = xcd_barrier_post((unsigned*)(A->ws + WS_CTL) + CW_BAR, MISC + 8, TID() == 0); }
#define GRID_BAR() xcd_barrier(bar, wave_s)
#endif

    if (IN(0)) {
        const KArgP A = KARG(); unsigned char* ws = A->ws;
        const int tid = TID(), lane = tid & 63, wave = wave_s;
        bf16_t* Win_t = WSP(bf16_t, WS_WIN); bf16_t* Wuq_t = WSP(bf16_t, WS_WUQ); bf16_t* Wukv_t = WSP(bf16_t, WS_WUKV);
        bf16_t* Wpd_t = WSP(bf16_t, WS_WPD); bf16_t* Wpm_t = WSP(bf16_t, WS_WPM); bf16_t* Wout_t = WSP(bf16_t, WS_WOUT);
        bf16_t* Hb = WSP(bf16_t, WS_H); float* Rope = WSP(float, WS_ROPE); unsigned short* Order = WSP(unsigned short, WS_ORDER);
        LAS float* scr = (LAS float*)(ldsl + wave * 16384);
        const int gw = bx * NWAVES + wave, NGW = G * NWAVES;
        constexpr int I_IN = 16 * (NINP / 32), I_UQ = 6 * 24, I_UKV = 4 * 32, I_PD = 8 * 32, I_PM = 8 * 32, I_OUT = 16 * 32;
        constexpr int NIT = I_IN + I_UQ + I_UKV + I_PD + I_PM + I_OUT;
        for (int it = gw; it < NIT; it += NGW) {
            int r = it;
            if (r < I_IN) { const int nb = r % (NINP / 32), kb = r / (NINP / 32); p0_transpose_item(A->w_in, 1024, NIN, Win_t, kb * 64, nb * 32, win_logical32(nb * 32), nullptr, scr, lane); continue; } r -= I_IN;
            if (r < I_UQ) { const int nb = r % 24, kb = r / 24; p0_transpose_item(A->w_uq, 384, 768, Wuq_t, kb * 64, nb * 32, wuq_logical32(nb * 32), A->qnorm, scr, lane); continue; } r -= I_UQ;
            if (r < I_UKV) { const int nb = r % 32, kb = r / 32; p0_transpose_item(A->w_ukv, 256, 1024, Wukv_t, kb * 64, nb * 32, nb * 32, A->kvnorm, scr, lane); continue; } r -= I_UKV;
            if (r < I_PD) { const int nb = r % 32, kb = r / 32; p0_transpose_item(A->wpd, 512, 1024, Wpd_t, kb * 64, nb * 32, nb * 32, nullptr, scr, lane); continue; } r -= I_PD;
            if (r < I_PM) { const int nb = r % 32, kb = r / 32; p0_transpose_item(A->wpm, 512, 1024, Wpm_t, kb * 64, nb * 32, nb * 32, nullptr, scr, lane); continue; } r -= I_PM;
            { const int nb = r % 32, kb = r / 32; p0_transpose_item(A->w_out, 1024, 1024, Wout_t, kb * 64, nb * 32, nb * 32, nullptr, scr, lane); }
        }
        for (int idx = bx * (NWAVES * 64) + tid; idx < S * 32; idx += G * NWAVES * 64) {
            const int row = idx >> 5, i = idx & 31;
            const float inv = (float)exp(-(double)(2 * i) / 64.0 * 9.210340371976184);
            const float ang = (float)A->pos[row] * inv;
            Rope[idx] = (float)cos((double)ang); Rope[(size_t)S * 32 + idx] = (float)sin((double)ang);
        }
        for (int m = gw; m < S; m += NGW) {
            const f32x4* xr = (const f32x4*)(A->x + (size_t)m * DM) + lane; const f32x4* gr = (const f32x4*)A->norm_in + lane;
            f32x4 v[4]; float s = 0.f;
#pragma unroll
            for (int j = 0; j < 4; ++j) { v[j] = xr[64 * j]; s += (v[j].x * v[j].x + v[j].y * v[j].y) + (v[j].z * v[j].z + v[j].w * v[j].w); }
            const float rstd = 1.0f / sqrtf(wave_sum(s) * (1.0f / DM) + NORM_EPS);
            unsigned long long* o8 = (unsigned long long*)(Hb + (size_t)m * DM) + lane;
#pragma unroll
            for (int j = 0; j < 4; ++j) { const f32x4 g = gr[64 * j];
                o8[64 * j] = (unsigned long long)cvtpk(v[j].x * rstd * g.x, v[j].y * rstd * g.y) | ((unsigned long long)cvtpk(v[j].z * rstd * g.z, v[j].w * rstd * g.w) << 32); }
        }
        if (bx == 0) {
            for (int e = tid; e < NITEMS; e += NWAVES * 64) { const int c = item_cost(e); int rank = 0;
                for (int f = 0; f < NITEMS; ++f) { const int cf = item_cost(f); rank += (cf > c || (cf == c && f < e)) ? 1 : 0; }
                Order[rank] = (unsigned short)e; }
        }
    }
    SEAM(0);

#ifndef SKIP_P1
    if (IN(1)) {
    {
        const KArgP A = KARG(); unsigned char* ws = A->ws; bf16_t* outb = (bf16_t*)A->out;
        pg8::Gemm g{WSP(bf16_t, WS_H), WSP(bf16_t, WS_WIN), S, NINP, 1024}; pg8::StaticOrder so; so.init(S, NINP, G, bx);
        EpiG1 E{WSP(bf16_t, WS_QD), WSP(bf16_t, WS_KD), WSP(bf16_t, WS_VD), WSP(bf16_t, WS_SGD), WSP(bf16_t, WS_CQ), WSP(bf16_t, WS_CKV), WSP(bf16_t, WS_KM), WSP(bf16_t, WS_SGM),
                outb, outb + (size_t)S * 1024, WSP(float, WS_SSQQ), WSP(float, WS_SSQKV), WSP(float, WS_ROPE)};
        pg8::gemm_phase<EpiG1, pg8::StaticOrder, true, true>(ldsl, g, so, E, wave_s);
    }
    }
#endif
    SEAM(1);

#ifndef SKIP_P2
    if (IN(2)) {
#ifndef SKIP_P2A
    {
        unsigned char* ws = KARG()->ws;
        pg8::Gemm g{WSP(bf16_t, WS_CQ), WSP(bf16_t, WS_WUQ), S, 768, 384}; pg8::StaticOrder so; so.init(S, 768, G, bx);
        EpiQ E{WSP(bf16_t, WS_QM), WSP(float, WS_SSQQ), WSP(float, WS_ROPE)};
        pg8::gemm_phase<EpiQ, pg8::StaticOrder, true, true>(ldsl, g, so, E, wave_s);
    }
#endif
#ifndef SKIP_P2B
    {
        unsigned char* ws = KARG()->ws;
        pg8::Gemm g{WSP(bf16_t, WS_CKV), WSP(bf16_t, WS_WUKV), S, 1024, 256}; pg8::StaticOrder so; so.init(S, 1024, G, bx);
        EpiKV E{WSP(bf16_t, WS_KM), WSP(bf16_t, WS_VM), WSP(float, WS_SSQKV)};
        pg8::gemm_phase<EpiKV, pg8::StaticOrder, true, true>(ldsl, g, so, E, wave_s);
    }
#endif
    }
#endif
    SEAM(2);

#ifndef SKIP_P3
    if (IN(3)) {
    {
        const KArgP A = KARG(); unsigned char* ws = A->ws; unsigned* ctl = (unsigned*)(ws + WS_CTL);
        bf16_t* Qd = WSP(bf16_t, WS_QD); bf16_t* Kd = WSP(bf16_t, WS_KD); bf16_t* Vd = WSP(bf16_t, WS_VD);
        bf16_t* Qm = WSP(bf16_t, WS_QM); bf16_t* Km = WSP(bf16_t, WS_KM); bf16_t* Vm = WSP(bf16_t, WS_VM);
        const unsigned short* Order = WSP(unsigned short, WS_ORDER);
        float lam;
        { const int ln = fresh_lane(); float v1 = A->lq1[ln] * A->lk1[ln], v2 = A->lq2[ln] * A->lk2[ln]; v1 = wave_sum(v1); v2 = wave_sum(v2); lam = expf(v1) - expf(v2) + LAMBDA_INIT; }
        const att::DiffEpi ED{WSP(bf16_t, WS_SGD), A->subln, WSP(bf16_t, WS_ODIFF), lam}; const att::MlaEpi EM{WSP(bf16_t, WS_SGM), WSP(bf16_t, WS_OMLA)};
#if STATIC_QUEUE
        for (int idx = bx; idx < NITEMS; idx += G) {
#else
        for (;;) {
            if (wave_s == 0 && fresh_lane() == 0) MISC[4] = xb_add(ctl + CW_QHEAD, 1u);
            __syncthreads();
            const int idx = (int)MISC[4];
            if (idx >= NITEMS) break;
#endif
            const int e = Order[idx];
#ifndef SKIP_DIFF
            if (e < NITEMS_D) { const int head = e & 3, qb = e >> 2;
                att::attn_unit<false>((char*)lds, Qd + (size_t)head * S * 128, Kd + (size_t)head * S * 128, Vd + (size_t)head * S * 128, qb * 128, head, ED, wave_s); }
#endif
#ifndef SKIP_MLA
            if (e >= NITEMS_D) { const int head = (e - NITEMS_D) & 3, qb = (e - NITEMS_D) >> 2;
                att::attn_unit<true>((char*)lds, Qm + (size_t)head * S * 192, Km + (size_t)head * S * 192, Vm + (size_t)head * S * 128, qb * 256, head, EM, wave_s); }
#endif
        }
    }
    }
#endif
    SEAM(3);

#ifndef SKIP_P4
    if (IN(4)) {
    {
        const KArgP A = KARG(); unsigned char* ws = A->ws;
        pg8::Gemm g{WSP(bf16_t, WS_ODIFF), WSP(bf16_t, WS_WPD), S, 1024, 512}; pg8::StaticOrder so; so.init(S, 1024, G, bx);
        EpiPA E{(const bf16_t*)A->out, WSP(float, WS_PART)};
        pg8::gemm_phase<EpiPA, pg8::StaticOrder, true, true>(ldsl, g, so, E, wave_s);
    }
    {
        const KArgP A = KARG(); unsigned char* ws = A->ws;
        pg8::Gemm g{WSP(bf16_t, WS_OMLA), WSP(bf16_t, WS_WPM), S, 1024, 512}; pg8::StaticOrder so; so.init(S, 1024, G, bx);
        EpiPB E{(const bf16_t*)A->out + (size_t)S * 1024, WSP(float, WS_PART), WSP(bf16_t, WS_MERGED)};
        pg8::gemm_phase<EpiPB, pg8::StaticOrder, true, true>(ldsl, g, so, E, wave_s);
    }
    }
#endif
    SEAM(4);

#ifndef SKIP_P5
    if (IN(5)) {
    {
        const KArgP A = KARG(); unsigned char* ws = A->ws;
        pg8::Gemm g{WSP(bf16_t, WS_MERGED), WSP(bf16_t, WS_WOUT), S, 1024, 1024}; pg8::StaticOrder so; so.init(S, 1024, G, bx);
        EpiOut E{A->x, A->out};
        pg8::gemm_phase<EpiOut, pg8::StaticOrder, true, true>(ldsl, g, so, E, wave_s);
    }
    }
#endif
    SEAM(5);

#ifndef SKIP_P6
    if (IN(6)) {
    {
        const KArgP A = KARG();
        const int lane6 = fresh_lane(), wave6 = wave_s;
        const int gw = bx * NWAVES + wave6, NGW = G * NWAVES;
        for (int m = gw; m < S; m += NGW) {
            f32x4* yr = (f32x4*)(A->out + (size_t)m * DM) + lane6; const f32x4* gr = (const f32x4*)A->norm_final + lane6;
            f32x4 v[4]; float s = 0.f;
#pragma unroll
            for (int j = 0; j < 4; ++j) { v[j] = yr[64 * j]; s += (v[j].x * v[j].x + v[j].y * v[j].y) + (v[j].z * v[j].z + v[j].w * v[j].w); }
            const float rstd = 1.0f / sqrtf(wave_sum(s) * (1.0f / DM) + NORM_EPS);
#pragma unroll
            for (int j = 0; j < 4; ++j) yr[64 * j] = v[j] * rstd * gr[64 * j];
        }
    }
    }
#endif
}

extern "C" void kernel_launch(void* const* d_in, const int* in_sizes, int n_in, void* d_out, int out_size, void* d_ws, size_t ws_size, hipStream_t stream) {
    static int grid = 0;
    if (grid == 0) {
        if (n_in != 17 || in_sizes[0] != S * DM || out_size != S * DM || ws_size < WS_END) {
            fprintf(stderr, "kernel_launch: unexpected shapes (n_in %d, in0 %d, out %d, ws %zu); nothing launched\n", n_in, n_in > 0 ? in_sizes[0] : -1, out_size, ws_size); grid = -1; return; }
        int dev = 0, cus = 0, per_cu = 0;
        if (hipGetDevice(&dev) != hipSuccess || hipDeviceGetAttribute(&cus, hipDeviceAttributeMultiprocessorCount, dev) != hipSuccess) { fprintf(stderr, "kernel_launch: device query failed\n"); grid = -1; return; }
        if (hipFuncSetAttribute((const void*)hybrid_fwd, hipFuncAttributeMaxDynamicSharedMemorySize, LDS_BYTES) != hipSuccess) { fprintf(stderr, "kernel_launch: hipFuncSetAttribute failed\n"); grid = -1; return; }
        if (hipOccupancyMaxActiveBlocksPerMultiprocessor(&per_cu, (const void*)hybrid_fwd, NWAVES * 64, LDS_BYTES) != hipSuccess || per_cu < 1) {
            fprintf(stderr, "kernel_launch: occupancy query reports %d workgroups per CU\n", per_cu); per_cu = 1; }
        (void)hipGetLastError();
        grid = cus * (per_cu < 1 ? 1 : per_cu);
    }
    if (grid < 0) return;
    if (hipMemsetAsync((char*)d_ws + WS_CTL, 0, CTL_ZERO_BYTES, stream) != hipSuccess) { fprintf(stderr, "kernel_launch: memset failed\n"); return; }
    Args a{};
    a.x = (const float*)d_in[0]; a.pos = (const int*)d_in[1]; a.norm_in = (const float*)d_in[2]; a.w_in = (const float*)d_in[3];
    a.lq1 = (const float*)d_in[4]; a.lk1 = (const float*)d_in[5]; a.lq2 = (const float*)d_in[6]; a.lk2 = (const float*)d_in[7];
    a.subln = (const float*)d_in[8]; a.qnorm = (const float*)d_in[9]; a.w_uq = (const float*)d_in[10]; a.kvnorm = (const float*)d_in[11];
    a.w_ukv = (const float*)d_in[12]; a.wpd = (const float*)d_in[13]; a.wpm = (const float*)d_in[14]; a.w_out = (const float*)d_in[15];
    a.norm_final = (const float*)d_in[16]; a.out = (float*)d_out; a.ws = (unsigned char*)d_ws; a.ph_lo = 0; a.ph_hi = 7;
#if N_LAUNCHES > 1
    for (int p = 0; p < 7; ++p) { a.ph_lo = p; a.ph_hi = p + 1; hipLaunchKernelGGL(hybrid_fwd, dim3(grid), dim3(NWAVES * 64), LDS_BYTES, stream, a); }
    const hipError_t le = hipPeekAtLastError();
#elif USE_CG_SYNC
    void* kargs[] = {(void*)&a};
    const hipError_t le = hipLaunchCooperativeKernel((const void*)hybrid_fwd, dim3(grid), dim3(NWAVES * 64), kargs, LDS_BYTES, stream);
#else
    hipLaunchKernelGGL(hybrid_fwd, dim3(grid), dim3(NWAVES * 64), LDS_BYTES, stream, a);
    const hipError_t le = hipPeekAtLastError();
#endif
    if (le != hipSuccess) fprintf(stderr, "kernel_launch: launch failed: %s\n", hipGetErrorName(le));
}
```

```cpp
#include <hip/hip_runtime.h>
#include <hip/hip_bf16.h>
#include <hip/hip_cooperative_groups.h>
#include <cstdio>
#include <cstdint>
#include <cmath>

__device__ __forceinline__ int fresh_lane() { int l; asm volatile("v_mbcnt_lo_u32_b32 %0, -1, 0\n\tv_mbcnt_hi_u32_b32 %0, -1, %0" : "=v"(l)); return l; }

namespace pg8 {
#define PG8_LAS __attribute__((address_space(3)))
typedef unsigned short bf16_t;
typedef short bf16x8 __attribute__((ext_vector_type(8)));
typedef float f32x4 __attribute__((ext_vector_type(4)));
typedef unsigned u32x4 __attribute__((ext_vector_type(4)));
constexpr int BM = 256, BK = 64, HALF = 128, HTB = HALF * BK * 2  , STAGE_BYTES = 8 * HTB, NXCD = 8, WGM = 8;

__host__ __device__ __forceinline__ int lds_byte(int r, int c) { const int st = (r >> 4) * 2 + (c >> 5), rr = r & 15, cc = c & 31, ob = rr * 64 + cc * 2; return st * 1024 + (ob ^ (((ob >> 9) & 1) << 5)); }
__host__ __device__ __forceinline__ void stage_rc(int b, int& R, int& C) { const int st = b / 1024, sb = b % 1024, swz = sb ^ (((sb >> 9) & 1) << 5); R = (st >> 1) * 16 + swz / 64; C = (st & 1) * 32 + (swz % 64) / 2; }
__host__ __device__ __forceinline__ int perm32(int rho) { const int n = rho >> 4, i = rho & 15; return 8 * (i >> 2) + 4 * n + (i & 3); }

struct Unit { int pm, pn; };
struct Gemm { const bf16_t* A; const bf16_t* Bt; int M, N, K; };

struct StaticOrder {
    int nM, nN, nwg, G, c;
    __host__ __device__ void init(int M, int N, int G_, int c_) { nM = M / BM; nN = N / BM; nwg = nM * nN; G = G_; c = c_; }
    __host__ __device__ bool next(int i, Unit& u) const {
        const long L = (long)i * G + c; if (L >= nwg) return false;
        int wgid = (int)L; { const int q = nwg / NXCD, r = nwg % NXCD, xcd = wgid % NXCD, off = wgid / NXCD; wgid = (xcd < r ? xcd * (q + 1) : r * (q + 1) + (xcd - r) * q) + off; }
        const int nig = WGM * nN, gid = wgid / nig, fm = gid * WGM, gsz = (nM - fm) < WGM ? (nM - fm) : WGM;
        u.pm = fm + ((wgid % nig) % gsz); u.pn = (wgid % nig) / gsz; return true;
    }
    __device__ __forceinline__ void a_ready(const Unit&) const {}
    __device__ __forceinline__ void done(const Unit&) const {}
};

template <class Epi, class Sched, bool ALIGN_EPI = false, bool SP2 = false>
__device__ __forceinline__ void gemm_phase(PG8_LAS unsigned char* lds, const Gemm g, const Sched& S, const Epi& E, const int wave_s) {
    const int tid_ = wave_s * 64 + fresh_lane();
    const int tid = tid_, wid = wave_s, lane = tid & 63, wr = wid >> 2, wc = wid & 3, fr = lane & 15, fq = lane >> 4;
    const int K = g.K, nt = K / BK;
    unsigned voffA[2], voffB[2];
#pragma unroll
    for (int i = 0; i < 2; ++i) { int R, C; stage_rc(tid * 16 + i * 8192, R, C); const int Rb = Epi::PERM ? ((R & ~31) + perm32(R & 31)) : R;
        voffA[i] = (unsigned)(R * K + C) * 2u; voffB[i] = (unsigned)(Rb * K + C) * 2u; }
    const size_t kstep = (size_t)(BK * 2);
    const size_t hstep = (size_t)HALF * K * 2;
    const size_t tstep = 2 * hstep;
    const unsigned ldsw = (unsigned)wid * 1024u;
    const int aoff = lds_byte(wr * 64 + fr, fq * 8), boff = lds_byte(wc * 32 + fr, fq * 8);
#define PG8_SA(b, h) (((b) * 2 + (h)) * HTB)
#define PG8_SB(b, h) ((4 + (b) * 2 + (h)) * HTB)
#define PG8_STAGE(bufoff, gbase, voff) do { _Pragma("unroll") for (int _i = 0; _i < 2; ++_i) \
        __builtin_amdgcn_global_load_lds((const unsigned*)((const char*)(gbase) + (voff)[_i]), (PG8_LAS unsigned*)(lds + (bufoff) + ldsw + _i * 8192), 16, 0, 0); } while (0)
#define PG8_LDA(dst, b, h) do { _Pragma("unroll") for (int m = 0; m < 4; ++m) _Pragma("unroll") for (int k = 0; k < 2; ++k) dst[m][k] = *(const PG8_LAS bf16x8*)(lds + PG8_SA(b, h) + aoff + m * 2048 + k * 1024); } while (0)
#define PG8_LDB(dst, b, h) do { _Pragma("unroll") for (int n = 0; n < 2; ++n) _Pragma("unroll") for (int k = 0; k < 2; ++k) dst[n][k] = *(const PG8_LAS bf16x8*)(lds + PG8_SB(b, h) + boff + n * 2048 + k * 1024); } while (0)
#define PG8_MMA(ai, bj, At, Bt) do { __builtin_amdgcn_s_setprio(1); _Pragma("unroll") for (int m = 0; m < 4; ++m) _Pragma("unroll") for (int n = 0; n < 2; ++n) _Pragma("unroll") for (int k = 0; k < 2; ++k) \
        acc[ai][bj][m][n] = __builtin_amdgcn_mfma_f32_16x16x32_bf16(Bt[n][k], At[m][k], acc[ai][bj][m][n], 0, 0, 0); __builtin_amdgcn_s_setprio(0); } while (0)
#define PG8_WAIT_V(n) asm volatile("s_waitcnt vmcnt(" #n ")" ::: "memory")
#define PG8_WAIT_L(n) asm volatile("s_waitcnt lgkmcnt(" #n ")" ::: "memory")
#define PG8_BAR __builtin_amdgcn_s_barrier()
#define PG8_SCHED __builtin_amdgcn_sched_barrier(0)
    Unit cur, nxt; int ui = 0;
    if (!S.next(0, cur)) return;
    f32x4 acc[2][2][4][2];
#pragma unroll
    for (int a = 0; a < 2; ++a)
#pragma unroll
        for (int b = 0; b < 2; ++b)
#pragma unroll
            for (int m = 0; m < 4; ++m)
#pragma unroll
                for (int n = 0; n < 2; ++n) acc[a][b][m][n] = (f32x4){0.f, 0.f, 0.f, 0.f};
    bf16x8 At[4][2], B0[2][2], B1[2][2];
    const char* cA = (const char*)g.A + (size_t)cur.pm * tstep; const char* cB = (const char*)g.Bt + (size_t)cur.pn * tstep;
    S.a_ready(cur);
    if constexpr (SP2) {
        PG8_STAGE(PG8_SB(0, 0), cB, voffB); PG8_STAGE(PG8_SB(0, 1), cB + hstep, voffB); PG8_STAGE(PG8_SA(0, 0), cA, voffA); PG8_STAGE(PG8_SA(0, 1), cA + hstep, voffA);
        if (wr == 1) PG8_BAR;
        PG8_WAIT_V(2); PG8_BAR;
        PG8_STAGE(PG8_SB(1, 0), cB + kstep, voffB); PG8_STAGE(PG8_SA(1, 0), cA + kstep, voffA); PG8_STAGE(PG8_SB(1, 1), cB + hstep + kstep, voffB);
        PG8_WAIT_V(6); PG8_BAR;
    } else {
        PG8_STAGE(PG8_SB(0, 0), cB, voffB); PG8_STAGE(PG8_SA(0, 0), cA, voffA); PG8_STAGE(PG8_SB(0, 1), cB + hstep, voffB); PG8_STAGE(PG8_SA(0, 1), cA + hstep, voffA);
        if (wr == 1) PG8_BAR;
        PG8_WAIT_V(4); PG8_BAR;
        PG8_STAGE(PG8_SB(1, 0), cB + kstep, voffB); PG8_STAGE(PG8_SA(1, 0), cA + kstep, voffA); PG8_STAGE(PG8_SB(1, 1), cB + hstep + kstep, voffB);
        PG8_WAIT_V(6); PG8_BAR;
    }
    for (;;) {
        const bool has_next = S.next(ui + 1, nxt);
        const char* nA = has_next ? (const char*)g.A + (size_t)nxt.pm * tstep : cA; const char* nB = has_next ? (const char*)g.Bt + (size_t)nxt.pn * tstep : cB;
        for (int t = 0; t < nt; t += 2) {
            const bool last = (t == nt - 2);
            const char* a1 = cA + (size_t)(t + 1) * kstep;
            const char* a2 = last ? nA : cA + (size_t)(t + 2) * kstep; const char* b2 = last ? nB : cB + (size_t)(t + 2) * kstep;
            const char* a3 = a2 + kstep; const char* b3 = b2 + kstep;
            if (last && has_next) S.a_ready(nxt);
            if constexpr (SP2) {
            PG8_LDB(B0, 0, 0); PG8_LDB(B1, 0, 1); PG8_SCHED; PG8_LDA(At, 0, 0); PG8_STAGE(PG8_SA(1, 1), a1 + hstep, voffA);
            PG8_WAIT_V(8); PG8_WAIT_L(0); PG8_BAR; PG8_MMA(0, 0, At, B0); PG8_MMA(0, 1, At, B1); PG8_BAR; PG8_SCHED;
            PG8_LDA(At, 0, 1); PG8_STAGE(PG8_SB(0, 0), b2, voffB); PG8_STAGE(PG8_SB(0, 1), b2 + hstep, voffB); PG8_STAGE(PG8_SA(0, 0), a2, voffA);
            PG8_WAIT_V(8); PG8_WAIT_L(0); PG8_BAR; PG8_MMA(1, 0, At, B0); PG8_MMA(1, 1, At, B1); PG8_BAR; PG8_SCHED;
            PG8_LDB(B0, 1, 0); PG8_LDB(B1, 1, 1); PG8_SCHED; PG8_LDA(At, 1, 0); PG8_STAGE(PG8_SA(0, 1), a2 + hstep, voffA);
            PG8_WAIT_V(8); PG8_WAIT_L(0); PG8_BAR; PG8_MMA(0, 0, At, B0); PG8_MMA(0, 1, At, B1); PG8_BAR; PG8_SCHED;
            PG8_LDA(At, 1, 1); PG8_STAGE(PG8_SB(1, 0), b3, voffB); PG8_STAGE(PG8_SB(1, 1), b3 + hstep, voffB); PG8_STAGE(PG8_SA(1, 0), a3, voffA);
            PG8_WAIT_V(8); PG8_WAIT_L(0); PG8_BAR; PG8_MMA(1, 0, At, B0); PG8_MMA(1, 1, At, B1); PG8_BAR; PG8_SCHED;
            } else {
            PG8_LDB(B0, 0, 0); PG8_SCHED; PG8_LDA(At, 0, 0); PG8_STAGE(PG8_SA(1, 1), a1 + hstep, voffA);
            PG8_WAIT_L(8); PG8_BAR; PG8_WAIT_L(0); PG8_MMA(0, 0, At, B0); PG8_BAR; PG8_SCHED;
            PG8_LDB(B1, 0, 1); PG8_STAGE(PG8_SB(0, 0), b2, voffB);
            PG8_BAR; PG8_WAIT_L(0); PG8_MMA(0, 1, At, B1); PG8_BAR;
            PG8_LDA(At, 0, 1); PG8_STAGE(PG8_SA(0, 0), a2, voffA);
            PG8_BAR; PG8_WAIT_L(0); PG8_MMA(1, 0, At, B0); PG8_BAR; PG8_SCHED;
            PG8_STAGE(PG8_SB(0, 1), b2 + hstep, voffB);
            PG8_WAIT_V(6); PG8_BAR; PG8_MMA(1, 1, At, B1); PG8_BAR;
            PG8_LDB(B0, 1, 0); PG8_SCHED; PG8_LDA(At, 1, 0); PG8_STAGE(PG8_SA(0, 1), a2 + hstep, voffA);
            PG8_WAIT_L(8); PG8_BAR; PG8_WAIT_L(0); PG8_MMA(0, 0, At, B0); PG8_BAR; PG8_SCHED;
            PG8_LDB(B1, 1, 1); PG8_STAGE(PG8_SB(1, 0), b3, voffB);
            PG8_BAR; PG8_WAIT_L(0); PG8_MMA(0, 1, At, B1); PG8_BAR;
            PG8_LDA(At, 1, 1); PG8_STAGE(PG8_SA(1, 0), a3, voffA);
            PG8_BAR; PG8_WAIT_L(0); PG8_MMA(1, 0, At, B0); PG8_BAR; PG8_SCHED;
            PG8_STAGE(PG8_SB(1, 1), b3 + hstep, voffB);
            PG8_WAIT_V(6); PG8_BAR; PG8_MMA(1, 1, At, B1); PG8_BAR;
            }
        }
        if constexpr (ALIGN_EPI) { if (wr == 0) PG8_BAR; }
        if constexpr (!Epi::AFTER_DRAIN) { E(acc, cur, wr, wc, fr, fq); S.done(cur); }
        if (!has_next) break;
#pragma unroll
        for (int a = 0; a < 2; ++a)
#pragma unroll
            for (int b = 0; b < 2; ++b)
#pragma unroll
                for (int m = 0; m < 4; ++m)
#pragma unroll
                    for (int n = 0; n < 2; ++n) acc[a][b][m][n] = (f32x4){0.f, 0.f, 0.f, 0.f};
        cur = nxt; cA = nA; cB = nB; ++ui;
        if constexpr (ALIGN_EPI) { if (wr == 1) PG8_BAR; }
    }
    PG8_WAIT_V(0);
    if constexpr (!ALIGN_EPI) { if (wr == 0) PG8_BAR; }
    PG8_BAR;
    if constexpr (Epi::AFTER_DRAIN) { E.fused(acc, cur, wr, wc, fr, fq, lds, wid, lane); S.done(cur); }
#undef PG8_SA
#undef PG8_SB
#undef PG8_STAGE
#undef PG8_LDA
#undef PG8_LDB
#undef PG8_MMA
#undef PG8_WAIT_V
#undef PG8_WAIT_L
#undef PG8_BAR
#undef PG8_SCHED
}
}

constexpr int S = 16384, DM = 1024;
constexpr int NIN = 5312, NINP = 5376;
constexpr float NORM_EPS = 1e-6f;
constexpr float LOG2E = 1.4426950408889634f;
constexpr float QSC_D = 0.125f * LOG2E;
constexpr float QSC_M = 0.07216878364870322f * LOG2E;
constexpr float LAMBDA_INIT = 0.2f;

typedef unsigned short bf16_t;
typedef short bf16x8 __attribute__((ext_vector_type(8)));
typedef float f32x4 __attribute__((ext_vector_type(4)));
typedef float f32x16 __attribute__((ext_vector_type(16)));
typedef unsigned u32x4 __attribute__((ext_vector_type(4)));
typedef short s16x4 __attribute__((ext_vector_type(4)));

constexpr size_t MiB = 1u << 20;
constexpr size_t WS_CTL = 0, CTL_ZERO_BYTES = 64 * 1024;
constexpr size_t WS_ORDER = 1 * MiB;
constexpr size_t WS_ROPE = 2 * MiB;
constexpr size_t WS_SSQQ = 6 * MiB;
constexpr size_t WS_SSQKV = 6 * MiB + 512 * 1024;
constexpr size_t WS_WIN = 8 * MiB;
constexpr size_t WS_WUQ = 19 * MiB;
constexpr size_t WS_WUKV = 20 * MiB;
constexpr size_t WS_WPD = 21 * MiB, WS_WPM = 22 * MiB;
constexpr size_t WS_WOUT = 23 * MiB;
constexpr size_t WS_H = 26 * MiB;
constexpr size_t WS_ODIFF = 26 * MiB, WS_OMLA = 42 * MiB;
constexpr size_t WS_QD = 58 * MiB, WS_KD = 74 * MiB, WS_VD = 90 * MiB, WS_SGD = 106 * MiB;
constexpr size_t WS_CQ = 122 * MiB, WS_CKV = 134 * MiB;
constexpr size_t WS_KM = 142 * MiB, WS_VM = 166 * MiB, WS_QM = 182 * MiB, WS_SGM = 206 * MiB;
constexpr size_t WS_MERGED = 58 * MiB;
constexpr size_t WS_PART = 142 * MiB;
constexpr size_t WS_END = 222 * MiB;

constexpr int CW_QHEAD = 64;
constexpr int CW_BAR = 1024;

typedef float f32x2_t __attribute__((ext_vector_type(2))); typedef __bf16 bf16x2_t __attribute__((ext_vector_type(2)));
__device__ __forceinline__ unsigned cvtpk(float lo, float hi) { f32x2_t v = {lo, hi}; bf16x2_t b = __builtin_convertvector(v, bf16x2_t); return __builtin_bit_cast(unsigned, b); }
__device__ __forceinline__ u32x4 pack8f(const float* v) { u32x4 w; w.x = cvtpk(v[0], v[1]); w.y = cvtpk(v[2], v[3]); w.z = cvtpk(v[4], v[5]); w.w = cvtpk(v[6], v[7]); return w; }
__device__ __forceinline__ float bf2f(bf16_t b) { return __uint_as_float(((unsigned)b) << 16); }
__device__ __forceinline__ float sigmoidf_(float x) { return __builtin_amdgcn_rcpf(1.0f + __builtin_amdgcn_exp2f(-x * LOG2E)); }
__device__ __forceinline__ float siluf_(float x) { return x * sigmoidf_(x); }

#define EPI_ROWS(...) _Pragma("unroll") for (int ai = 0; ai < 2; ++ai) _Pragma("unroll") for (int m = 0; m < 4; ++m) { const int row = rbase + ai * 128 + m * 16; __VA_ARGS__ if (m & 1) asm volatile("" ::: "memory"); }
#define EPI_ROWS1(...) _Pragma("unroll") for (int ai = 0; ai < 2; ++ai) _Pragma("unroll") for (int m = 0; m < 4; ++m) { const int row = rbase + ai * 128 + m * 16; __VA_ARGS__ asm volatile("" ::: "memory"); }
#define EPI_V8(dst, bj) float dst[8]; { const f32x4 a_ = acc[ai][bj][m][0], b_ = acc[ai][bj][m][1]; dst[0] = a_[0]; dst[1] = a_[1]; dst[2] = a_[2]; dst[3] = a_[3]; dst[4] = b_[0]; dst[5] = b_[1]; dst[6] = b_[2]; dst[7] = b_[3]; }

__device__ __forceinline__ void rope8(const float* __restrict__ rope, int row, int i0, const float* x1, const float* x2, float sc, float* o1, float* o2) {
    const f32x4 c0 = *(const f32x4*)(rope + (size_t)row * 32 + i0), c1 = *(const f32x4*)(rope + (size_t)row * 32 + i0 + 4);
    const f32x4 s0 = *(const f32x4*)(rope + (size_t)S * 32 + (size_t)row * 32 + i0), s1 = *(const f32x4*)(rope + (size_t)S * 32 + (size_t)row * 32 + i0 + 4);
#pragma unroll
    for (int j = 0; j < 8; ++j) { const float c = j < 4 ? c0[j & 3] : c1[j & 3], s = j < 4 ? s0[j & 3] : s1[j & 3];
        o1[j] = (x1[j] * c - x2[j] * s) * sc; o2[j] = (x2[j] * c + x1[j] * s) * sc; }
}

struct EpiG1 {
    static constexpr bool PERM = true, AFTER_DRAIN = false;
    bf16_t *Qd, *Kd, *Vd, *sgd, *cq, *ckv, *Km, *sgm, *gsd, *gsm; float *ssq_q, *ssq_kv; const float* rope;
    __device__ __forceinline__ void operator()(const f32x4 (&acc)[2][2][4][2], const pg8::Unit& u, int wr, int wc, int fr_, int fq_) const {
        const int ln_ = fresh_lane(), fr = ln_ & 15, fq = ln_ >> 4;
        const int pn = u.pn, rbase = u.pm * 256 + wr * 64 + fr, ch = wc * 32 + fq * 8;
        if (pn < 4) {
            bf16_t* base = pn < 2 ? Qd : Kd; const float sc = pn < 2 ? QSC_D : 1.0f;
            const int head = 2 * (pn & 1) + (wc >> 1), map = wc & 1, i0 = fq * 8;
            EPI_ROWS( EPI_V8(x1, 0) EPI_V8(x2, 1) float o1[8], o2[8]; rope8(rope, row, i0, x1, x2, sc, o1, o2);
                bf16_t* d = base + ((size_t)head * S + row) * 128 + map * 64 + i0; *(u32x4*)d = pack8f(o1); *(u32x4*)(d + 32) = pack8f(o2); )
        } else if (pn < 6) {
            EPI_ROWS( _Pragma("unroll") for (int bj = 0; bj < 2; ++bj) { EPI_V8(v, bj) const int head = 2 * (pn - 4) + bj;
                *(u32x4*)(Vd + ((size_t)head * S + row) * 128 + ch) = pack8f(v); } )
        } else if (pn < 8 || pn == 11 || pn == 12) {
            bf16_t* base = pn < 8 ? sgd : sgm; const int c0 = (pn < 8 ? pn - 6 : pn - 11) * 256 + ch;
            EPI_ROWS( _Pragma("unroll") for (int bj = 0; bj < 2; ++bj) { EPI_V8(v, bj) _Pragma("unroll") for (int j = 0; j < 8; ++j) v[j] = siluf_(v[j]);
                *(u32x4*)(base + (size_t)row * 512 + c0 + bj * 128) = pack8f(v); } )
        } else if (pn == 8) {
            EPI_ROWS( float ss = 0.f; _Pragma("unroll") for (int bj = 0; bj < 2; ++bj) { EPI_V8(v, bj) _Pragma("unroll") for (int j = 0; j < 8; ++j) ss += v[j] * v[j];
                *(u32x4*)(cq + (size_t)row * 384 + bj * 128 + ch) = pack8f(v); }
                ss += __shfl_xor(ss, 16); ss += __shfl_xor(ss, 32); if (fq == 0) ssq_q[(size_t)row * 4 + wc] = ss; )
        } else if (pn == 9) {
            if (wc < 3) {
                EPI_ROWS( EPI_V8(v0, 0) EPI_V8(v1, 1) float ss = 0.f; _Pragma("unroll") for (int j = 0; j < 8; ++j) ss += v0[j] * v0[j] + v1[j] * v1[j];
                    *(u32x4*)(cq + (size_t)row * 384 + 256 + ch) = pack8f(v0); if (wc == 0) *(u32x4*)(cq + (size_t)row * 384 + 352 + fq * 8) = pack8f(v1);
                    ss += __shfl_xor(ss, 16); ss += __shfl_xor(ss, 32); if (fq == 0) ssq_q[(size_t)S * 4 + (size_t)row * 4 + wc] = ss; )
            } else {
                const int i0 = fq * 8;
                EPI_ROWS( EPI_V8(x1, 0) EPI_V8(x2, 1) float o1[8], o2[8]; rope8(rope, row, i0, x1, x2, 1.0f, o1, o2); const u32x4 w1 = pack8f(o1), w2 = pack8f(o2);
                    _Pragma("unroll") for (int h = 0; h < 4; ++h) { bf16_t* d = Km + ((size_t)h * S + row) * 192 + 128 + i0; *(u32x4*)d = w1; *(u32x4*)(d + 32) = w2; } )
            }
        } else if (pn == 10) {
            EPI_ROWS( float ss = 0.f; _Pragma("unroll") for (int bj = 0; bj < 2; ++bj) { EPI_V8(v, bj) _Pragma("unroll") for (int j = 0; j < 8; ++j) ss += v[j] * v[j];
                *(u32x4*)(ckv + (size_t)row * 256 + bj * 128 + ch) = pack8f(v); }
                ss += __shfl_xor(ss, 16); ss += __shfl_xor(ss, 32); if (fq == 0) ssq_kv[(size_t)row * 4 + wc] = ss; )
        } else {
            bf16_t* base = pn < 17 ? gsd : gsm; const int c0 = (pn < 17 ? pn - 13 : pn - 17) * 256 + ch;
            EPI_ROWS( _Pragma("unroll") for (int bj = 0; bj < 2; ++bj) { EPI_V8(v, bj) _Pragma("unroll") for (int j = 0; j < 8; ++j) v[j] = sigmoidf_(v[j]);
                *(u32x4*)(base + (size_t)row * 1024 + c0 + bj * 128) = pack8f(v); } )
        }
    }
};

struct EpiQ {
    static constexpr bool PERM = true, AFTER_DRAIN = false;
    bf16_t* Qm; const float* ssq_q; const float* rope;
    __device__ __forceinline__ void operator()(const f32x4 (&acc)[2][2][4][2], const pg8::Unit& u, int wr, int wc, int fr_, int fq_) const {
        const int ln_ = fresh_lane(), fr = ln_ & 15, fq = ln_ >> 4;
        const int pn = u.pn, rbase = u.pm * 256 + wr * 64 + fr, ch = wc * 32 + fq * 8;
        EPI_ROWS1(
            const f32x4 sa = *(const f32x4*)(ssq_q + (size_t)row * 4), sb = *(const f32x4*)(ssq_q + (size_t)S * 4 + (size_t)row * 4);
            const float rstd = __builtin_amdgcn_rsqf(((sa[0] + sa[1]) + (sa[2] + sa[3]) + (sb[0] + sb[1]) + sb[2]) * (1.0f / 384.0f) + NORM_EPS);
            if (pn == 0) { EPI_V8(x1, 0) EPI_V8(x2, 1) float o1[8], o2[8]; rope8(rope, row, fq * 8, x1, x2, rstd * QSC_M, o1, o2);
                bf16_t* d = Qm + ((size_t)wc * S + row) * 192 + 128 + fq * 8; *(u32x4*)d = pack8f(o1); *(u32x4*)(d + 32) = pack8f(o2); }
            else { _Pragma("unroll") for (int bj = 0; bj < 2; ++bj) { EPI_V8(v, bj) _Pragma("unroll") for (int j = 0; j < 8; ++j) v[j] *= rstd * QSC_M;
                const int head = 2 * (pn - 1) + bj; *(u32x4*)(Qm + ((size_t)head * S + row) * 192 + ch) = pack8f(v); } } )
    }
};
struct EpiKV {
    static constexpr bool PERM = true, AFTER_DRAIN = false;
    bf16_t *Km, *Vm; const float* ssq_kv;
    __device__ __forceinline__ void operator()(const f32x4 (&acc)[2][2][4][2], const pg8::Unit& u, int wr, int wc, int fr_, int fq_) const {
        const int ln_ = fresh_lane(), fr = ln_ & 15, fq = ln_ >> 4;
        const int head = u.pn, rbase = u.pm * 256 + wr * 64 + fr, ch = wc * 32 + fq * 8;
        EPI_ROWS1(
            const f32x4 sa = *(const f32x4*)(ssq_kv + (size_t)row * 4);
            const float rstd = __builtin_amdgcn_rsqf(((sa[0] + sa[1]) + (sa[2] + sa[3])) * (1.0f / 256.0f) + NORM_EPS);
            { EPI_V8(v, 0) _Pragma("unroll") for (int j = 0; j < 8; ++j) v[j] *= rstd; *(u32x4*)(Km + ((size_t)head * S + row) * 192 + ch) = pack8f(v); }
            { EPI_V8(v, 1) _Pragma("unroll") for (int j = 0; j < 8; ++j) v[j] *= rstd; *(u32x4*)(Vm + ((size_t)head * S + row) * 128 + ch) = pack8f(v); } )
    }
};
struct EpiPA {
    static constexpr bool PERM = true, AFTER_DRAIN = false;
    const bf16_t* gs; float* part;
    __device__ __forceinline__ void operator()(const f32x4 (&acc)[2][2][4][2], const pg8::Unit& u, int wr, int wc, int fr_, int fq_) const {
        const int ln_ = fresh_lane(), fr = ln_ & 15, fq = ln_ >> 4;
        const int rbase = u.pm * 256 + wr * 64 + fr, c0 = u.pn * 256 + wc * 32 + fq * 8;
        EPI_ROWS( _Pragma("unroll") for (int bj = 0; bj < 2; ++bj) { EPI_V8(v, bj) const size_t off = (size_t)row * 1024 + c0 + bj * 128;
            const bf16x8 g = *(const bf16x8*)(gs + off); _Pragma("unroll") for (int j = 0; j < 8; ++j) v[j] *= bf2f((bf16_t)g[j]);
            *(f32x4*)(part + off) = (f32x4){v[0], v[1], v[2], v[3]}; *(f32x4*)(part + off + 4) = (f32x4){v[4], v[5], v[6], v[7]}; } )
    }
};
struct EpiPB {
    static constexpr bool PERM = true, AFTER_DRAIN = false;
    const bf16_t* gs; const float* part; bf16_t* merged;
    __device__ __forceinline__ void operator()(const f32x4 (&acc)[2][2][4][2], const pg8::Unit& u, int wr, int wc, int fr_, int fq_) const {
        const int ln_ = fresh_lane(), fr = ln_ & 15, fq = ln_ >> 4;
        const int rbase = u.pm * 256 + wr * 64 + fr, c0 = u.pn * 256 + wc * 32 + fq * 8;
        EPI_ROWS( _Pragma("unroll") for (int bj = 0; bj < 2; ++bj) { EPI_V8(v, bj) const size_t off = (size_t)row * 1024 + c0 + bj * 128;
            const bf16x8 g = *(const bf16x8*)(gs + off); const f32x4 p0 = *(const f32x4*)(part + off), p1 = *(const f32x4*)(part + off + 4);
            _Pragma("unroll") for (int j = 0; j < 8; ++j) v[j] = v[j] * bf2f((bf16_t)g[j]) + (j < 4 ? p0[j & 3] : p1[j & 3]);
            *(u32x4*)(merged + off) = pack8f(v); } )
    }
};
struct EpiOut {
    static constexpr bool PERM = true, AFTER_DRAIN = false;
    const float* x; float* y;
    __device__ __forceinline__ void operator()(const f32x4 (&acc)[2][2][4][2], const pg8::Unit& u, int wr, int wc, int fr_, int fq_) const {
        const int ln_ = fresh_lane(), fr = ln_ & 15, fq = ln_ >> 4;
        const int rbase = u.pm * 256 + wr * 64 + fr, c0 = u.pn * 256 + wc * 32 + fq * 8;
        EPI_ROWS( _Pragma("unroll") for (int bj = 0; bj < 2; ++bj) { const size_t off = (size_t)row * 1024 + c0 + bj * 128;
            *(f32x4*)(y + off) = *(const f32x4*)(x + off) + acc[ai][bj][m][0]; *(f32x4*)(y + off + 4) = *(const f32x4*)(x + off + 4) + acc[ai][bj][m][1]; } )
    }
};

namespace att {
#define SBAR() __builtin_amdgcn_sched_barrier(0)
constexpr int SHM_V = 64 * 128 * 2;
#ifndef MLA_NQR
#define MLA_NQR 12
#endif
constexpr int LDS_V = 0, LDS_K = 2 * SHM_V, LDS_WS = LDS_K + 2 * 64 * 192 * 2  , LDS_QST = LDS_WS + 8 * 256, LDS_END = LDS_QST + 8 * (12 - MLA_NQR) * 1024;
constexpr int XP = 132;
constexpr float THR = 8.f;
__device__ __forceinline__ int v_st(int k, int c) { const int kk = (k & ~0xC) | ((k & 4) << 1) | ((k & 8) >> 1); return ((kk >> 3) * 4 + (c >> 5)) * 512 + ((kk & 7) * 32 + (c & 31)) * 2; }
__device__ __forceinline__ int v_rd_base(int lane) { return ((lane & 3) << 3) | (((lane >> 2) & 3) << 6) | (((lane >> 4) & 1) << 5) | (((lane >> 5) & 1) << 8); }
constexpr int v_rd_off(int d0, int ks, int half) { return d0 * 512 + ks * 4096 + half * 2048; }
__device__ __forceinline__ int crow(int r, int hi) { return (r & 3) + 8 * (r >> 2) + 4 * hi; }
__device__ __forceinline__ void mask_tile(f32x16& p0, f32x16& p1, int dq) {
    const float NEG = -__builtin_inff();
#pragma unroll
    for (int r = 0; r < 16; ++r) { const int c = (r & 3) + 8 * (r >> 2); if (dq - c < 0) p0[r] = NEG; if (dq - c - 32 < 0) p1[r] = NEG; }
}
__device__ __forceinline__ void partialSM(f32x16& p0, f32x16& p1, float& m_reg, float& alpha) {
    float pmax = p0[0];
#pragma unroll
    for (int r = 1; r < 16; ++r) pmax = fmaxf(pmax, p0[r]);
#pragma unroll
    for (int r = 0; r < 16; ++r) pmax = fmaxf(pmax, p1[r]);
    { auto rr = __builtin_amdgcn_permlane32_swap(__float_as_uint(pmax), __float_as_uint(pmax), false, false);
      pmax = fmaxf(__uint_as_float(rr[0]), __uint_as_float(rr[1])); }
    float mn;
    if (__builtin_expect(__all(pmax - m_reg <= THR), 1)) { mn = m_reg; alpha = 1.f; }
    else { mn = fmaxf(m_reg, pmax); alpha = __builtin_amdgcn_exp2f(m_reg - mn); m_reg = mn; }
#pragma unroll
    for (int r = 0; r < 16; ++r) p0[r] = p0[r] - mn;
#pragma unroll
    for (int r = 0; r < 16; ++r) p1[r] = p1[r] - mn;
#pragma unroll
    for (int r = 0; r < 16; ++r) p0[r] = __builtin_amdgcn_exp2f(p0[r]);
}
__device__ __forceinline__ void finishSM(f32x16& p0, f32x16& p1, float alpha, float& l_reg, bf16x8& pa0, bf16x8& pa1, bf16x8& pa2, bf16x8& pa3) {
#pragma unroll
    for (int r = 0; r < 16; ++r) p1[r] = __builtin_amdgcn_exp2f(p1[r]);
    float ps = 0;
#pragma unroll
    for (int r = 0; r < 16; ++r) ps += p0[r];
#pragma unroll
    for (int r = 0; r < 16; ++r) ps += p1[r];
    { auto rr = __builtin_amdgcn_permlane32_swap(__float_as_uint(ps), __float_as_uint(ps), false, false);
      ps = __uint_as_float(rr[0]) + __uint_as_float(rr[1]); }
    l_reg = l_reg * alpha + ps;
#define PK4(P, B_, OUT) do { unsigned a0 = cvtpk(P[B_+0], P[B_+1]), a1 = cvtpk(P[B_+2], P[B_+3]);                          \
        unsigned b0 = cvtpk(P[B_+4], P[B_+5]), b1 = cvtpk(P[B_+6], P[B_+7]);                                             \
        auto r0 = __builtin_amdgcn_permlane32_swap(a0, b0, false, false); auto r1 = __builtin_amdgcn_permlane32_swap(a1, b1, false, false); \
        u32x4 w = {r0[0], r1[0], r0[1], r1[1]}; OUT = *reinterpret_cast<bf16x8*>(&w); } while (0)
    PK4(p0, 0, pa0); PK4(p0, 8, pa1); PK4(p1, 0, pa2); PK4(p1, 8, pa3);
#undef PK4
}
template <int NK, int KROWB, int NQR>
__device__ __forceinline__ void qkt(f32x16& p0, f32x16& p1, const char* Kb, int r32, int hi, const bf16x8* qr, const char* qst) {
    p0 = f32x16{}; p1 = f32x16{};
    const char* kb[4];
#pragma unroll
    for (int dd = 0; dd < 4; ++dd) kb[dd] = Kb + r32 * KROWB + (((dd * 16 + hi * 8) * 2) ^ ((r32 & 7) << 4));
#pragma unroll
    for (int d0 = 0; d0 < NK; ++d0) { const char* a = kb[d0 & 3] + (d0 >> 2) * 128;
#ifdef QKT_SB
        if (NK > 4 && d0 > 0 && (d0 % QKT_SB) == 0) SBAR();
#endif
        bf16x8 b0 = *reinterpret_cast<const bf16x8*>(a);
        bf16x8 b1 = *reinterpret_cast<const bf16x8*>(a + 32 * KROWB);
        bf16x8 qf; if (d0 < NQR) qf = qr[d0]; else qf = *reinterpret_cast<const bf16x8*>(qst + (d0 - NQR) * 1024);
        p0 = __builtin_amdgcn_mfma_f32_32x32x16_bf16(b0, qf, p0, 0, 0, 0);
        p1 = __builtin_amdgcn_mfma_f32_32x32x16_bf16(b1, qf, p1, 0, 0, 0); }
}
template <int VB>
__device__ __forceinline__ void pv_tile(f32x16* o, int vb0, bf16x8 pa0, bf16x8 pa1, bf16x8 pa2, bf16x8 pa3) {
#define TRRD(dst, off) asm volatile("ds_read_b64_tr_b16 %0, %1 offset:%2" : "=&v"(dst) : "v"(vb0), "i"(off) : "memory")
#define PV_D0(d0) do { s16x4 l0, l1, l2, l3, h0, h1, h2, h3; constexpr int b_ = VB * SHM_V + v_rd_off(d0, 0, 0); \
        TRRD(l0, b_); TRRD(h0, b_ + 2048); TRRD(l1, b_ + 4096); TRRD(h1, b_ + 6144); TRRD(l2, b_ + 8192); TRRD(h2, b_ + 10240); TRRD(l3, b_ + 12288); TRRD(h3, b_ + 14336); \
        asm volatile("s_waitcnt lgkmcnt(0)" ::: "memory"); SBAR();   \
        o[d0] = __builtin_amdgcn_mfma_f32_32x32x16_bf16(pa0, (bf16x8){l0[0], l0[1], l0[2], l0[3], h0[0], h0[1], h0[2], h0[3]}, o[d0], 0, 0, 0);   \
        o[d0] = __builtin_amdgcn_mfma_f32_32x32x16_bf16(pa1, (bf16x8){l1[0], l1[1], l1[2], l1[3], h1[0], h1[1], h1[2], h1[3]}, o[d0], 0, 0, 0);   \
        o[d0] = __builtin_amdgcn_mfma_f32_32x32x16_bf16(pa2, (bf16x8){l2[0], l2[1], l2[2], l2[3], h2[0], h2[1], h2[2], h2[3]}, o[d0], 0, 0, 0);   \
        o[d0] = __builtin_amdgcn_mfma_f32_32x32x16_bf16(pa3, (bf16x8){l3[0], l3[1], l3[2], l3[3], h3[0], h3[1], h3[2], h3[3]}, o[d0], 0, 0, 0); } while (0)
    PV_D0(0); PV_D0(1); PV_D0(2); PV_D0(3);
#undef PV_D0
#undef TRRD
}

struct DiffEpi { const bf16_t* sgd; const float* subln; bf16_t* out; float lam; };
struct MlaEpi { const bf16_t* sgm; bf16_t* out; };

template <bool MLA, class Epi>
__device__ __forceinline__ void attn_unit(char* lds, const bf16_t* __restrict__ Qh, const bf16_t* __restrict__ Kh, const bf16_t* __restrict__ Vh, int P0, int head, const Epi& E, const int wave_s) {
    constexpr int KD = MLA ? 192 : 128, NK = MLA ? 12 : 4, NQR = MLA ? MLA_NQR : 4, QB = MLA ? 256 : 128, KROWB = KD * 2, SHM_K = 64 * KROWB, CPR = KD / 8, NCH = (64 * CPR) / 512;
    const int tid = wave_s * 64 + fresh_lane(), wid = wave_s, lane = tid & 63, r32 = lane & 31, hi = lane >> 5;
    const int map = MLA ? 0 : (wid >> 2), wrow = MLA ? wid * 32 : (wid & 3) * 32;
    const int NT = (P0 + QB) / 64;
    const int qlo = P0 + wrow, qm = qlo + r32 - 4 * hi;
    char* V_lds = lds + LDS_V; char* K_lds = lds + LDS_K;
    float* ws = (float*)(lds + LDS_WS) + wid * 64; float* li_l = ws; float* al_l = ws + 32;
    float m_reg = -1e30f, l_reg = 0.f; f32x16 o[4] = {};
    int ksrc[NCH], kdst[NCH];
#pragma unroll
    for (int j = 0; j < NCH; ++j) { const int c = tid + 512 * j, row = c / CPR, chk = c % CPR; ksrc[j] = row * KD + chk * 8; kdst[j] = row * KROWB + ((chk * 16) ^ ((row & 7) << 4)); }
    const int sr = tid >> 4, sc = (tid & 15) * 8, vst0 = v_st(sr, sc), vst1 = v_st(32 + sr, sc);
    const int vb0 = (int)(uintptr_t)V_lds + v_rd_base(lane);
    bf16x8 st_k[NCH], st_v0, st_v1;
#define SLOAD(t) do { const bf16_t* kp_ = Kh + (size_t)(t) * 64 * KD; const bf16_t* vp_ = Vh + (size_t)(t) * 64 * 128;                              \
        st_v0 = *(const bf16x8*)(vp_ + sr * 128 + sc); st_v1 = *(const bf16x8*)(vp_ + (32 + sr) * 128 + sc);                                         \
        _Pragma("unroll") for (int j = 0; j < NCH; ++j) st_k[j] = *(const bf16x8*)(kp_ + ksrc[j]); } while (0)
#define SWRITE(bf) do { *(bf16x8*)(V_lds + (bf) * SHM_V + vst0) = st_v0; *(bf16x8*)(V_lds + (bf) * SHM_V + vst1) = st_v1;                           \
        _Pragma("unroll") for (int j = 0; j < NCH; ++j) *(bf16x8*)(K_lds + (bf) * SHM_K + kdst[j]) = st_k[j]; } while (0)
#define VMW() asm volatile("s_waitcnt vmcnt(0)" ::: "memory")
#define RESC(a) do { if (__any((a) < 1.f)) { if (hi == 0) al_l[r32] = (a); asm volatile("s_waitcnt lgkmcnt(0)" ::: "memory");              \
                     _Pragma("unroll") for (int d_ = 0; d_ < 4; ++d_) _Pragma("unroll") for (int r = 0; r < 16; ++r) o[d_][r] *= al_l[crow(r, hi)]; } } while (0)
#define MASKT(PX0, PX1, t) do { const int kb_ = (t) * 64; if (kb_ + 63 > qlo) mask_tile(PX0, PX1, qm - kb_); } while (0)
#define KBUF(b) (K_lds + (b) * SHM_K + map * 128)
    bf16x8 qr[NQR]; char* qst = lds + LDS_QST + wid * ((12 - MLA_NQR) * 1024) + lane * 16;
    { const bf16_t* qp = Qh + (size_t)(qlo + r32) * KD + map * 64 + hi * 8;
#pragma unroll
      for (int d0 = 0; d0 < NK; ++d0) { const bf16x8 qv = *(const bf16x8*)(qp + d0 * 16); if (d0 < NQR) qr[d0] = qv; else *(bf16x8*)(qst + (d0 - NQR) * 1024) = qv; } }
    f32x16 pA0, pA1; float alA; bf16x8 pa0, pa1, pa2, pa3;
  if constexpr (MLA) {
    SLOAD(0); VMW(); SWRITE(0);
    __syncthreads();
#define STEP1(t, B) do {                                                                                                       \
        if ((t) + 1 < NT) { SLOAD((t) + 1); SBAR(); }                                                                          \
        qkt<NK, KROWB, NQR>(pA0, pA1, KBUF(B), r32, hi, qr, qst);                                                              \
        MASKT(pA0, pA1, (t)); partialSM(pA0, pA1, m_reg, alA); RESC(alA);                                                      \
        finishSM(pA0, pA1, alA, l_reg, pa0, pa1, pa2, pa3); SBAR();                                                            \
        pv_tile<B>(o, vb0, pa0, pa1, pa2, pa3);                                                                                \
        if ((t) + 1 < NT) { VMW(); SWRITE(1 - (B)); }                                                                          \
        __syncthreads(); } while (0)
    for (int t = 0; t < NT; t += 2) { STEP1(t, 0); STEP1(t + 1, 1); }
#undef STEP1
  } else {
    f32x16 pB0, pB1; float alB;
    SLOAD(0); VMW(); SWRITE(0); SBAR();
    SLOAD(1);
    __syncthreads();
    qkt<NK, KROWB, NQR>(pA0, pA1, KBUF(0), r32, hi, qr, qst);
    MASKT(pA0, pA1, 0); partialSM(pA0, pA1, m_reg, alA);
    VMW(); SWRITE(1);
    __syncthreads();
#define HALF_STEP(PX0, PX1, alX, PY0, PY1, alY, t, KB, VB) do {                                                              \
        SBAR(); qkt<NK, KROWB, NQR>(PX0, PX1, KBUF(KB), r32, hi, qr, qst);                                                     \
        finishSM(PY0, PY1, alY, l_reg, pa0, pa1, pa2, pa3); SBAR();                                                            \
        if ((t) + 1 < NT) { SLOAD((t) + 1); SBAR(); }                                                                          \
        pv_tile<VB>(o, vb0, pa0, pa1, pa2, pa3); MASKT(PX0, PX1, (t)); partialSM(PX0, PX1, m_reg, alX);                       \
        __syncthreads();                                                                                                       \
        if ((t) + 1 < NT) { VMW(); SWRITE(VB); }                                                                               \
        RESC(alX); __syncthreads(); } while (0)
    int t = 1;
    for (; t + 1 < NT; t += 2) {
        HALF_STEP(pB0, pB1, alB, pA0, pA1, alA, t, 1, 0);
        HALF_STEP(pA0, pA1, alA, pB0, pB1, alB, t + 1, 0, 1);
    }
#undef HALF_STEP
    SBAR(); qkt<NK, KROWB, NQR>(pB0, pB1, KBUF(1), r32, hi, qr, qst); SBAR();
    finishSM(pA0, pA1, alA, l_reg, pa0, pa1, pa2, pa3); SBAR();
    pv_tile<0>(o, vb0, pa0, pa1, pa2, pa3);
    MASKT(pB0, pB1, NT - 1); partialSM(pB0, pB1, m_reg, alB); RESC(alB);
    finishSM(pB0, pB1, alB, l_reg, pa0, pa1, pa2, pa3); SBAR(); pv_tile<1>(o, vb0, pa0, pa1, pa2, pa3);
  }
    if (hi == 0) li_l[r32] = l_reg; asm volatile("s_waitcnt lgkmcnt(0)" ::: "memory");
    float rli[16];
#pragma unroll
    for (int r = 0; r < 16; ++r) rli[r] = __builtin_amdgcn_rcpf(li_l[crow(r, hi)]);
    if constexpr (MLA) {
#pragma unroll
        for (int r = 0; r < 16; ++r) { const size_t g0 = (size_t)(qlo + crow(r, hi)) * 512 + head * 128 + r32;
#pragma unroll
            for (int d0 = 0; d0 < 4; ++d0) { const float v = o[d0][r] * rli[r] * bf2f(E.sgm[g0 + d0 * 32]); const float vn = __shfl_xor(v, 1);
                if ((r32 & 1) == 0) *(unsigned*)(E.out + g0 + d0 * 32) = cvtpk(v, vn); } }
        __syncthreads();
    } else {
        float* X = (float*)lds;
        __syncthreads();
        if (map == 1) {
#pragma unroll
            for (int r = 0; r < 16; ++r)
#pragma unroll
                for (int d0 = 0; d0 < 4; ++d0) X[(wrow + crow(r, hi)) * XP + d0 * 32 + r32] = E.lam * o[d0][r] * rli[r];
        }
        __syncthreads();
        if (map == 0) {
            float ssq[16];
#pragma unroll
            for (int r = 0; r < 16; ++r) { float s = 0.f;
#pragma unroll
                for (int d0 = 0; d0 < 4; ++d0) { const float v = o[d0][r] * rli[r] - X[(wrow + crow(r, hi)) * XP + d0 * 32 + r32]; o[d0][r] = v; s += v * v; }
                ssq[r] = s; }
#pragma unroll
            for (int off = 1; off < 32; off <<= 1)
#pragma unroll
                for (int r = 0; r < 16; ++r) ssq[r] += __shfl_xor(ssq[r], off);
            float gl[4];
#pragma unroll
            for (int d0 = 0; d0 < 4; ++d0) gl[d0] = E.subln[d0 * 32 + r32] * (1.0f - LAMBDA_INIT);
#pragma unroll
            for (int r = 0; r < 16; ++r) { const float rstd = __builtin_amdgcn_rsqf(ssq[r] * (1.0f / 128.0f) + NORM_EPS);
                const size_t g0 = (size_t)(qlo + crow(r, hi)) * 512 + head * 128 + r32;
#pragma unroll
                for (int d0 = 0; d0 < 4; ++d0) { const float v = o[d0][r] * rstd * gl[d0] * bf2f(E.sgd[g0 + d0 * 32]); const float vn = __shfl_xor(v, 1);
                    if ((r32 & 1) == 0) *(unsigned*)(E.out + g0 + d0 * 32) = cvtpk(v, vn); } }
        }
        __syncthreads();
    }
#undef SLOAD
#undef SWRITE
#undef VMW
#undef RESC
#undef MASKT
#undef KBUF
}
#undef SBAR
}

#ifndef N_LAUNCHES
#define N_LAUNCHES 1
#endif
#ifndef REP_PHASE
#define REP_PHASE -1
#endif
#ifndef STATIC_QUEUE
#define STATIC_QUEUE 0
#endif
#ifndef USE_CG_SYNC
#define USE_CG_SYNC 0
#endif
constexpr int NWAVES = 8;
constexpr int RING_BYTES = 131072;
constexpr int LDSCTL_OFF = RING_BYTES, MISC_OFF = LDSCTL_OFF + 320;
constexpr int LDS_BYTES = 147456;
static_assert(att::LDS_END <= RING_BYTES && MISC_OFF + 128 <= LDS_BYTES, "LDS map");

#define GAS __attribute__((address_space(1)))
#define LAS __attribute__((address_space(3)))
typedef GAS unsigned gu32;
#define RLX_AGENT __ATOMIC_RELAXED, __HIP_MEMORY_SCOPE_AGENT
#define LDS_WAIT() asm volatile("s_waitcnt lgkmcnt(0)" ::: "memory")

#define XB_TMO      128
#define XB_XCNT(j)  (256  + 64 * (j))
#define XB_XSUB(j)  (1280 + 64 * (j))
#define XB_XGEN(j)  (2304 + 64 * (j))
#define XB_TOP      3328
#define XB_TOPGEN   3392
#define XCD_BAR_WORDS 3456
#define XB_SPIN_CAP (1u << 18)
__device__ __forceinline__ unsigned xb_ld(unsigned* p)              { return __hip_atomic_load(p, __ATOMIC_RELAXED, __HIP_MEMORY_SCOPE_AGENT); }
__device__ __forceinline__ unsigned xb_add(unsigned* p, unsigned v) { return __hip_atomic_fetch_add(p, v, __ATOMIC_RELAXED, __HIP_MEMORY_SCOPE_AGENT); }
__device__ __forceinline__ unsigned xb_xcc_id() { return (unsigned)__builtin_amdgcn_s_getreg((3 << 11) | 20) & 0xFu; }
#define XB_SPIN(cond, bar) do { unsigned _sp = 0; while (cond) { __builtin_amdgcn_s_sleep(1); \
    if ((++_sp & 255u) == 0u) { if (xb_ld(&(bar)[XB_TMO])) break; if (_sp > XB_SPIN_CAP) { atomicAdd(&(bar)[XB_TMO], 1u); break; } } } } while (0)
struct XcdBarrier { unsigned* bar; unsigned x; volatile LAS unsigned* st; };
__device__ __forceinline__ XcdBarrier xcd_barrier_post(unsigned* bar, volatile LAS unsigned* st, bool t0) {
    XcdBarrier b; b.bar = bar; b.x = xb_xcc_id(); b.st = st;
    if (t0) (void)xb_add(&bar[XB_XCNT(b.x)], 1u);
    return b;
}
__device__ __forceinline__ void xcd_barrier_complete(unsigned* bar, unsigned x, unsigned& nloc, unsigned& nx) {
    const unsigned G = gridDim.x * gridDim.y * gridDim.z;
    unsigned sum, cnt, mine, sp = 0u;
    for (;;) {
        sum = 0u; cnt = 0u; mine = 0u;
#pragma unroll
        for (unsigned j = 0; j < 16; ++j) { const unsigned c = xb_ld(&bar[XB_XCNT(j)]); sum += c; cnt += (c > 0u) ? 1u : 0u; mine = (j == x) ? c : mine; }
        if (sum == G) break;
        __builtin_amdgcn_s_sleep(1);
        if ((++sp & 255u) == 0u) { if (xb_ld(&bar[XB_TMO])) break; if (sp > XB_SPIN_CAP) { atomicAdd(&bar[XB_TMO], 1u); break; } }
    }
    nloc = mine > 0u ? mine : 1u; nx = cnt > 0u ? cnt : 1u;
}
__device__ __forceinline__ void xcd_barrier(const XcdBarrier& b, const int wave_s) {
    asm volatile("s_waitcnt vmcnt(0)" ::: "memory");
    __syncthreads();
    if (wave_s == 0 && fresh_lane() == 0) {
        unsigned* bar = b.bar;
        __builtin_amdgcn_s_waitcnt(0);
        unsigned nloc = b.st[0], nx = b.st[1];
        if (nloc == 0u) { xcd_barrier_complete(bar, b.x, nloc, nx); b.st[0] = nloc; b.st[1] = nx; }
        const unsigned old = xb_add(&bar[XB_XSUB(b.x)], 1u);
        const unsigned gen = old / nloc;
        if (old + 1u == (gen + 1u) * nloc) {
            __builtin_amdgcn_fence(__ATOMIC_RELEASE, "agent");
            asm volatile("s_waitcnt vmcnt(0)" ::: "memory");
            const unsigned og = xb_add(&bar[XB_TOP], 1u);
            const unsigned tg = og / nx;
            if (og + 1u == (tg + 1u) * nx) xb_add(&bar[XB_TOPGEN], 1u);
            else XB_SPIN(xb_ld(&bar[XB_TOPGEN]) == tg, bar);
            __builtin_amdgcn_fence(__ATOMIC_ACQUIRE, "agent");
            xb_add(&bar[XB_XGEN(b.x)], 1u);
            asm volatile("s_waitcnt vmcnt(0)" ::: "memory");
        } else {
            XB_SPIN(xb_ld(&bar[XB_XGEN(b.x)]) == gen, bar);
            __builtin_amdgcn_fence(__ATOMIC_ACQUIRE, "agent");
            asm volatile("s_waitcnt vmcnt(0)" ::: "memory");
        }
    }
    __syncthreads();
}

__device__ __forceinline__ float wave_sum(float v) {
#pragma unroll
    for (int o = 1; o < 64; o <<= 1) v += __shfl_xor(v, o);
    return v;
}
__host__ __device__ inline int win_logical32(int p0) {
    const int pn = p0 >> 8, pl = p0 & 255;
    if (pn < 4) { const int half = pl >> 7, g = (pl & 127) >> 5, head = 2 * (pn & 1) + (g >> 1), map = g & 1; return (pn < 2 ? 0 : 512) + head * 128 + map * 64 + half * 32; }
    if (pn < 8) return 1024 + (p0 - 4 * 256);
    if (pn == 8) return 2048 + pl;
    if (pn == 9) { if (pl < 96) return 2048 + 256 + pl; if (pl < 128) return 2688; if (pl < 160) return 2048 + 352; if (pl < 224) return -1; return 2688 + 32; }
    if (pn == 10) return 2432 + pl;
    return 2752 + (p0 - 11 * 256);
}
__host__ __device__ inline int wuq_logical32(int p0) {
    if (p0 < 256) { const int half = p0 >> 7, head = (p0 & 127) >> 5; return head * 192 + 128 + half * 32; }
    const int pl = p0 - 256, head = pl >> 7; return head * 192 + (pl & 127);
}
__device__ __forceinline__ void p0_transpose_item(const float* W, int K, int N, bf16_t* WT, int k0, int p0, int lsrc, const float* gain, LAS float* scr, int lane) {
#pragma unroll 8
    for (int i = 0; i < 32; ++i) { const int kk = 2 * i + (lane >> 5);
        float v = 0.f; if (lsrc >= 0) { v = W[(size_t)(k0 + kk) * N + lsrc + (lane & 31)]; if (gain) v *= gain[k0 + kk]; }
        scr[kk * 33 + (lane & 31)] = v; }
    LDS_WAIT(); asm volatile("" ::: "memory");
    const int c = lane & 7;
#pragma unroll
    for (int j = 0; j < 4; ++j) { const int n = (lane >> 3) + 8 * j; const LAS float* s = scr + (8 * c) * 33 + n;
        u32x4 o; o.x = cvtpk(s[0 * 33], s[1 * 33]); o.y = cvtpk(s[2 * 33], s[3 * 33]); o.z = cvtpk(s[4 * 33], s[5 * 33]); o.w = cvtpk(s[6 * 33], s[7 * 33]);
        *(u32x4*)(WT + (size_t)(p0 + n) * K + k0 + 8 * c) = o; }
    LDS_WAIT(); asm volatile("" ::: "memory");
}

struct Args { const float* x; const int* pos; const float* norm_in; const float* w_in; const float* lq1; const float* lk1; const float* lq2; const float* lk2;
              const float* subln; const float* qnorm; const float* w_uq; const float* kvnorm; const float* w_ukv; const float* wpd; const float* wpm; const float* w_out;
              const float* norm_final; float* out; unsigned char* ws; int ph_lo, ph_hi; };

constexpr int NITEMS_D = 512, NITEMS_M = 256, NITEMS = NITEMS_D + NITEMS_M;
__device__ __forceinline__ int item_cost(int e) { if (e < NITEMS_D) return (2 * ((e >> 2) + 1) + 2) * 10; const int j = (e - NITEMS_D) >> 2; return (4 * (j + 1) + 2) * 17; }

__global__ void __launch_bounds__(NWAVES * 64, 2) hybrid_fwd(Args a_unused) {
    extern __shared__ __attribute__((aligned(16))) unsigned char lds[];
    LAS unsigned char* ldsl = (LAS unsigned char*)lds;
    volatile LAS unsigned* MISC = (volatile LAS unsigned*)(ldsl + MISC_OFF);
    const int G = gridDim.x, bx = blockIdx.x;
    const int wave_s = __builtin_amdgcn_readfirstlane(threadIdx.x >> 6);
#define TID() (wave_s * 64 + fresh_lane())
    typedef const Args __attribute__((address_space(4)))* KArgP;
    const KArgP kargs = (KArgP)__builtin_amdgcn_kernarg_segment_ptr();
#define KARG() ({ KArgP p_ = kargs; asm volatile("" : "+s"(p_)); p_; })
#define WSP(T, off) ((T*)(ws + (off)))
    const int ph_lo = kargs->ph_lo, ph_hi = kargs->ph_hi;
#define IN(k) (ph_lo <= (k) && (k) < ph_hi)
#ifdef PROBE_A
#define TSTAMP(k) do { if (bx == 0 && wave_s == 0 && fresh_lane() == 0) { ((unsigned long long*)(KARG()->ws + WS_CTL + 32768))[k] = __builtin_amdgcn_s_memrealtime(); } } while (0)
#else
#define TSTAMP(k) do { } while (0)
#endif
#define SEAM(k) do { if (IN(k) && IN((k) + 1)) { GRID_BAR(); TSTAMP((k) + 1); } } while (0)
    {
        for (int u = TID(); u < (LDS_BYTES - LDSCTL_OFF) / 4; u += NWAVES * 64) ((LAS unsigned*)(ldsl + LDSCTL_OFF))[u] = 0u;
        __syncthreads();
    }
#if USE_CG_SYNC
    cooperative_groups::grid_group cgrid = cooperative_groups::this_grid();
#define GRID_BAR() cgrid.sync()
#else
    XcdBarrier bar;
    { const KArgP A = KARG(); bar = xcd_barrier_post((unsigned*)(A->ws + WS_CTL) + CW_BAR, MISC + 8, TID() == 0); }
#define GRID_BAR() xcd_barrier(bar, wave_s)
#endif

    TSTAMP(0);
    if (IN(0)) for (int rep_ = 0; rep_ < (REP_PHASE == 0 ? 2 : 1); ++rep_) { if (rep_) GRID_BAR();
        const KArgP A = KARG(); unsigned char* ws = A->ws;
        const int tid = TID(), lane = tid & 63, wave = wave_s;
        bf16_t* Win_t = WSP(bf16_t, WS_WIN); bf16_t* Wuq_t = WSP(bf16_t, WS_WUQ); bf16_t* Wukv_t = WSP(bf16_t, WS_WUKV);
        bf16_t* Wpd_t = WSP(bf16_t, WS_WPD); bf16_t* Wpm_t = WSP(bf16_t, WS_WPM); bf16_t* Wout_t = WSP(bf16_t, WS_WOUT);
        bf16_t* Hb = WSP(bf16_t, WS_H); float* Rope = WSP(float, WS_ROPE); unsigned short* Order = WSP(unsigned short, WS_ORDER);
        LAS float* scr = (LAS float*)(ldsl + wave * 16384);
        const int gw = bx * NWAVES + wave, NGW = G * NWAVES;
        constexpr int I_IN = 16 * (NINP / 32), I_UQ = 6 * 24, I_UKV = 4 * 32, I_PD = 8 * 32, I_PM = 8 * 32, I_OUT = 16 * 32;
        constexpr int NIT = I_IN + I_UQ + I_UKV + I_PD + I_PM + I_OUT;
        for (int it = gw; it < NIT; it += NGW) {
            int r = it;
            if (r < I_IN) { const int nb = r % (NINP / 32), kb = r / (NINP / 32); p0_transpose_item(A->w_in, 1024, NIN, Win_t, kb * 64, nb * 32, win_logical32(nb * 32), nullptr, scr, lane); continue; } r -= I_IN;
            if (r < I_UQ) { const int nb = r % 24, kb = r / 24; p0_transpose_item(A->w_uq, 384, 768, Wuq_t, kb * 64, nb * 32, wuq_logical32(nb * 32), A->qnorm, scr, lane); continue; } r -= I_UQ;
            if (r < I_UKV) { const int nb = r % 32, kb = r / 32; p0_transpose_item(A->w_ukv, 256, 1024, Wukv_t, kb * 64, nb * 32, nb * 32, A->kvnorm, scr, lane); continue; } r -= I_UKV;
            if (r < I_PD) { const int nb = r % 32, kb = r / 32; p0_transpose_item(A->wpd, 512, 1024, Wpd_t, kb * 64, nb * 32, nb * 32, nullptr, scr, lane); continue; } r -= I_PD;
            if (r < I_PM) { const int nb = r % 32, kb = r / 32; p0_transpose_item(A->wpm, 512, 1024, Wpm_t, kb * 64, nb * 32, nb * 32, nullptr, scr, lane); continue; } r -= I_PM;
            { const int nb = r % 32, kb = r / 32; p0_transpose_item(A->w_out, 1024, 1024, Wout_t, kb * 64, nb * 32, nb * 32, nullptr, scr, lane); }
        }
        { const int i = tid & 31;
          const float inv = (float)exp(-(double)(2 * i) / 64.0 * 9.210340371976184);
          for (int idx = bx * (NWAVES * 64) + tid; idx < S * 32; idx += G * NWAVES * 64) {
            const int row = idx >> 5;
            const float ang = (float)A->pos[row] * inv;
            const double rev = (double)ang * 0.15915494309189535; const float fr = (float)(rev - rint(rev));
            Rope[idx] = __builtin_amdgcn_cosf(fr); Rope[(size_t)S * 32 + idx] = __builtin_amdgcn_sinf(fr);
          } }
        for (int m = gw; m < S; m += NGW) {
            const f32x4* xr = (const f32x4*)(A->x + (size_t)m * DM) + lane; const f32x4* gr = (const f32x4*)A->norm_in + lane;
            f32x4 v[4]; float s = 0.f;
#pragma unroll
            for (int j = 0; j < 4; ++j) { v[j] = xr[64 * j]; s += (v[j].x * v[j].x + v[j].y * v[j].y) + (v[j].z * v[j].z + v[j].w * v[j].w); }
            const float rstd = 1.0f / sqrtf(wave_sum(s) * (1.0f / DM) + NORM_EPS);
            unsigned long long* o8 = (unsigned long long*)(Hb + (size_t)m * DM) + lane;
#pragma unroll
            for (int j = 0; j < 4; ++j) { const f32x4 g = gr[64 * j];
                o8[64 * j] = (unsigned long long)cvtpk(v[j].x * rstd * g.x, v[j].y * rstd * g.y) | ((unsigned long long)cvtpk(v[j].z * rstd * g.z, v[j].w * rstd * g.w) << 32); }
        }
        for (int e = gw; e < NITEMS; e += NGW) {
            const int c = item_cost(e); int rank = 0;
            for (int f = lane; f < NITEMS; f += 64) { const int cf = item_cost(f); rank += (cf > c || (cf == c && f < e)) ? 1 : 0; }
            rank = (int)wave_sum((float)rank);
            if (lane == 0) Order[rank] = (unsigned short)e;
        }
    }
    SEAM(0);

#ifndef SKIP_P1
    if (IN(1)) for (int rep_ = 0; rep_ < (REP_PHASE == 1 ? 2 : 1); ++rep_) { if (rep_) GRID_BAR();
    {
        const KArgP A = KARG(); unsigned char* ws = A->ws; bf16_t* outb = (bf16_t*)A->out;
        pg8::Gemm g{WSP(bf16_t, WS_H), WSP(bf16_t, WS_WIN), S, NINP, 1024}; pg8::StaticOrder so; so.init(S, NINP, G, bx);
        EpiG1 E{WSP(bf16_t, WS_QD), WSP(bf16_t, WS_KD), WSP(bf16_t, WS_VD), WSP(bf16_t, WS_SGD), WSP(bf16_t, WS_CQ), WSP(bf16_t, WS_CKV), WSP(bf16_t, WS_KM), WSP(bf16_t, WS_SGM),
                outb, outb + (size_t)S * 1024, WSP(float, WS_SSQQ), WSP(float, WS_SSQKV), WSP(float, WS_ROPE)};
        pg8::gemm_phase<EpiG1, pg8::StaticOrder, true, true>(ldsl, g, so, E, wave_s);
    }
    }
#endif
    SEAM(1);

#ifndef SKIP_P2
    if (IN(2)) for (int rep_ = 0; rep_ < (REP_PHASE == 2 ? 2 : 1); ++rep_) { if (rep_) GRID_BAR();
#ifndef SKIP_P2A
    {
        unsigned char* ws = KARG()->ws;
        pg8::Gemm g{WSP(bf16_t, WS_CQ), WSP(bf16_t, WS_WUQ), S, 768, 384}; pg8::StaticOrder so; so.init(S, 768, G, bx);
        EpiQ E{WSP(bf16_t, WS_QM), WSP(float, WS_SSQQ), WSP(float, WS_ROPE)};
        pg8::gemm_phase<EpiQ, pg8::StaticOrder, true, true>(ldsl, g, so, E, wave_s);
    }
#endif
#ifndef SKIP_P2B
    {
        unsigned char* ws = KARG()->ws;
        pg8::Gemm g{WSP(bf16_t, WS_CKV), WSP(bf16_t, WS_WUKV), S, 1024, 256}; pg8::StaticOrder so; so.init(S, 1024, G, bx);
        EpiKV E{WSP(bf16_t, WS_KM), WSP(bf16_t, WS_VM), WSP(float, WS_SSQKV)};
        pg8::gemm_phase<EpiKV, pg8::StaticOrder, true, true>(ldsl, g, so, E, wave_s);
    }
#endif
    }
#endif
    SEAM(2);

#ifndef SKIP_P3
    if (IN(3)) for (int rep_ = 0; rep_ < (REP_PHASE == 3 ? 2 : 1); ++rep_) { if (rep_) GRID_BAR();
    {
        const KArgP A = KARG(); unsigned char* ws = A->ws; unsigned* ctl = (unsigned*)(ws + WS_CTL);
        bf16_t* Qd = WSP(bf16_t, WS_QD); bf16_t* Kd = WSP(bf16_t, WS_KD); bf16_t* Vd = WSP(bf16_t, WS_VD);
        bf16_t* Qm = WSP(bf16_t, WS_QM); bf16_t* Km = WSP(bf16_t, WS_KM); bf16_t* Vm = WSP(bf16_t, WS_VM);
        const unsigned short* Order = WSP(unsigned short, WS_ORDER);
        float lam;
        { const int ln = fresh_lane(); float v1 = A->lq1[ln] * A->lk1[ln], v2 = A->lq2[ln] * A->lk2[ln]; v1 = wave_sum(v1); v2 = wave_sum(v2); lam = expf(v1) - expf(v2) + LAMBDA_INIT; }
        const att::DiffEpi ED{WSP(bf16_t, WS_SGD), A->subln, WSP(bf16_t, WS_ODIFF), lam}; const att::MlaEpi EM{WSP(bf16_t, WS_SGM), WSP(bf16_t, WS_OMLA)};
#if STATIC_QUEUE
        for (int idx = bx; idx < NITEMS; idx += G) {
#else
        for (;;) {
            if (wave_s == 0 && fresh_lane() == 0) MISC[4] = xb_add(ctl + CW_QHEAD, 1u);
            __syncthreads();
            const int idx = (int)MISC[4];
            if (idx >= NITEMS) break;
#endif
            const int e = Order[idx];
#ifndef SKIP_DIFF
            if (e < NITEMS_D) { const int head = e & 3, qb = e >> 2;
                att::attn_unit<false>((char*)lds, Qd + (size_t)head * S * 128, Kd + (size_t)head * S * 128, Vd + (size_t)head * S * 128, qb * 128, head, ED, wave_s); }
#endif
#ifndef SKIP_MLA
            if (e >= NITEMS_D) { const int head = (e - NITEMS_D) & 3, qb = (e - NITEMS_D) >> 2;
                att::attn_unit<true>((char*)lds, Qm + (size_t)head * S * 192, Km + (size_t)head * S * 192, Vm + (size_t)head * S * 128, qb * 256, head, EM, wave_s); }
#endif
        }
    }
    }
#endif
    SEAM(3);

#ifndef SKIP_P4
    if (IN(4)) for (int rep_ = 0; rep_ < (REP_PHASE == 4 ? 2 : 1); ++rep_) { if (rep_) GRID_BAR();
    {
        const KArgP A = KARG(); unsigned char* ws = A->ws;
        pg8::Gemm g{WSP(bf16_t, WS_ODIFF), WSP(bf16_t, WS_WPD), S, 1024, 512}; pg8::StaticOrder so; so.init(S, 1024, G, bx);
        EpiPA E{(const bf16_t*)A->out, WSP(float, WS_PART)};
        pg8::gemm_phase<EpiPA, pg8::StaticOrder, true, true>(ldsl, g, so, E, wave_s);
    }
    {
        const KArgP A = KARG(); unsigned char* ws = A->ws;
        pg8::Gemm g{WSP(bf16_t, WS_OMLA), WSP(bf16_t, WS_WPM), S, 1024, 512}; pg8::StaticOrder so; so.init(S, 1024, G, bx);
        EpiPB E{(const bf16_t*)A->out + (size_t)S * 1024, WSP(float, WS_PART), WSP(bf16_t, WS_MERGED)};
        pg8::gemm_phase<EpiPB, pg8::StaticOrder, true, true>(ldsl, g, so, E, wave_s);
    }
    }
#endif
    SEAM(4);

#ifndef SKIP_P5
    if (IN(5)) for (int rep_ = 0; rep_ < (REP_PHASE == 5 ? 2 : 1); ++rep_) { if (rep_) GRID_BAR();
    {
        const KArgP A = KARG(); unsigned char* ws = A->ws;
        pg8::Gemm g{WSP(bf16_t, WS_MERGED), WSP(bf16_t, WS_WOUT), S, 1024, 1024}; pg8::StaticOrder so; so.init(S, 1024, G, bx);
        EpiOut E{A->x, A->out};
        pg8::gemm_phase<EpiOut, pg8::StaticOrder, true, true>(ldsl, g, so, E, wave_s);
    }
    }
#endif
    SEAM(5);

#ifndef SKIP_P6
    if (IN(6)) for (int rep_ = 0; rep_ < (REP_PHASE == 6 ? 2 : 1); ++rep_) { if (rep_) GRID_BAR();
    {
        const KArgP A = KARG();
        const int lane6 = fresh_lane(), wave6 = wave_s;
        const int gw = bx * NWAVES + wave6, NGW = G * NWAVES;
        for (int m = gw; m < S; m += NGW) {
            f32x4* yr = (f32x4*)(A->out + (size_t)m * DM) + lane6; const f32x4* gr = (const f32x4*)A->norm_final + lane6;
            f32x4 v[4]; float s = 0.f;
#pragma unroll
            for (int j = 0; j < 4; ++j) { v[j] = yr[64 * j]; s += (v[j].x * v[j].x + v[j].y * v[j].y) + (v[j].z * v[j].z + v[j].w * v[j].w); }
            const float rstd = 1.0f / sqrtf(wave_sum(s) * (1.0f / DM) + NORM_EPS);
#ifdef PROBE_A
            const unsigned long long* tsp = (const unsigned long long*)(A->ws + WS_CTL + 32768);
            const float c1 = (float)(tsp[PROBE_A + 1] - tsp[PROBE_A]) * 0.01f * 0.001f, c2 = (float)(tsp[PROBE_B + 1] - tsp[PROBE_B]) * 0.01f * 0.01f;
#pragma unroll
            for (int j = 0; j < 4; ++j) { f32x4 ov = v[j] * rstd * gr[64 * j] + c1; if (m == 0 && lane6 == 0 && j == 0) ov.x += c2 - c1; yr[64 * j] = ov; }
#else
#pragma unroll
            for (int j = 0; j < 4; ++j) yr[64 * j] = v[j] * rstd * gr[64 * j];
#endif
        }
    }
    }
#endif
}

extern "C" void kernel_launch(void* const* d_in, const int* in_sizes, int n_in, void* d_out, int out_size, void* d_ws, size_t ws_size, hipStream_t stream) {
    static int grid = 0;
    if (grid == 0) {
        if (n_in != 17 || in_sizes[0] != S * DM || out_size != S * DM || ws_size < WS_END) {
            fprintf(stderr, "kernel_launch: unexpected shapes (n_in %d, in0 %d, out %d, ws %zu); nothing launched\n", n_in, n_in > 0 ? in_sizes[0] : -1, out_size, ws_size); grid = -1; return; }
        int dev = 0, cus = 0, per_cu = 0;
        if (hipGetDevice(&dev) != hipSuccess || hipDeviceGetAttribute(&cus, hipDeviceAttributeMultiprocessorCount, dev) != hipSuccess) { fprintf(stderr, "kernel_launch: device query failed\n"); grid = -1; return; }
        if (hipFuncSetAttribute((const void*)hybrid_fwd, hipFuncAttributeMaxDynamicSharedMemorySize, LDS_BYTES) != hipSuccess) { fprintf(stderr, "kernel_launch: hipFuncSetAttribute failed\n"); grid = -1; return; }
        if (hipOccupancyMaxActiveBlocksPerMultiprocessor(&per_cu, (const void*)hybrid_fwd, NWAVES * 64, LDS_BYTES) != hipSuccess || per_cu < 1) {
            fprintf(stderr, "kernel_launch: occupancy query reports %d workgroups per CU\n", per_cu); per_cu = 1; }
        (void)hipGetLastError();
        grid = cus * (per_cu < 1 ? 1 : per_cu);
    }
    if (grid < 0) return;
    if (hipMemsetAsync((char*)d_ws + WS_CTL, 0, CTL_ZERO_BYTES, stream) != hipSuccess) { fprintf(stderr, "kernel_launch: memset failed\n"); return; }
    Args a{};
    a.x = (const float*)d_in[0]; a.pos = (const int*)d_in[1]; a.norm_in = (const float*)d_in[2]; a.w_in = (const float*)d_in[3];
    a.lq1 = (const float*)d_in[4]; a.lk1 = (const float*)d_in[5]; a.lq2 = (const float*)d_in[6]; a.lk2 = (const float*)d_in[7];
    a.subln = (const float*)d_in[8]; a.qnorm = (const float*)d_in[9]; a.w_uq = (const float*)d_in[10]; a.kvnorm = (const float*)d_in[11];
    a.w_ukv = (const float*)d_in[12]; a.wpd = (const float*)d_in[13]; a.wpm = (const float*)d_in[14]; a.w_out = (const float*)d_in[15];
    a.norm_final = (const float*)d_in[16]; a.out = (float*)d_out; a.ws = (unsigned char*)d_ws; a.ph_lo = 0; a.ph_hi = 7;
#if N_LAUNCHES > 1
    for (int p = 0; p < 7; ++p) { a.ph_lo = p; a.ph_hi = p + 1; hipLaunchKernelGGL(hybrid_fwd, dim3(grid), dim3(NWAVES * 64), LDS_BYTES, stream, a); }
    const hipError_t le = hipPeekAtLastError();
#elif USE_CG_SYNC
    void* kargs[] = {(void*)&a};
    const hipError_t le = hipLaunchCooperativeKernel((const void*)hybrid_fwd, dim3(grid), dim3(NWAVES * 64), kargs, LDS_BYTES, stream);
#else
    hipLaunchKernelGGL(hybrid_fwd, dim3(grid), dim3(NWAVES * 64), LDS_BYTES, stream, a);
    const hipError_t le = hipPeekAtLastError();
#endif
    if (le != hipSuccess) fprintf(stderr, "kernel_launch: launch failed: %s\n", hipGetErrorName(le));
}
```
